# Optimizing an MI355X kernel written in HIP

```python
import math
import jax, jax.numpy as jnp
from jax import lax
import numpy as np

D_MODEL = 1024
BATCH = 2
SEQ = 8192
DEPTH = 4

POOL_WIDTH = D_MODEL // 4
FOURIER_WIDTH = D_MODEL // 4
ATTN_WIDTH = D_MODEL // 2
POOL_WINDOWS = (2, 4, 8, 16)
N_POOL_GROUPS = len(POOL_WINDOWS)
POOL_GROUP_DIM = POOL_WIDTH // N_POOL_GROUPS
N_FOURIER_GROUPS = 4
FOURIER_GROUP_DIM = FOURIER_WIDTH // N_FOURIER_GROUPS
ATTN_HEADS = 4
ATTN_HEAD_DIM = ATTN_WIDTH // (2 * ATTN_HEADS)
ATTN_V_DIM = 2 * ATTN_HEAD_DIM
Q_BLOCK = 128
D_FF = 2816
IN_COLS = POOL_WIDTH + FOURIER_WIDTH + 3 * ATTN_WIDTH
NORM_EPS = 1e-6

kernel_name = "hybrid_pool_fourier_diffattn_macaron_encoder"


def alibi_slopes(n_heads):
    return jnp.array([2.0 ** (-8.0 * (i + 1) / n_heads) for i in range(n_heads)], dtype=jnp.float32)


def lambda_init_fn(layer_idx):
    return 0.8 - 0.6 * math.exp(-0.3 * layer_idx)


def rmsnorm(x, g):
    xf = x.astype(jnp.float32)
    y = xf * lax.rsqrt(jnp.mean(xf * xf, axis=-1, keepdims=True) + NORM_EPS)
    return (y * g.astype(jnp.float32)).astype(x.dtype)


def swiglu(x, w_gate, w_up, w_down):
    return (jax.nn.silu(x @ w_gate) * (x @ w_up)) @ w_down


def pool_mixer(a, pool_w, pool_scale):
    B, S, _ = a.shape
    af = a.reshape(B, S, N_POOL_GROUPS, POOL_GROUP_DIM).astype(jnp.float32)
    prefix = jnp.concatenate(
        [jnp.zeros((B, 1, N_POOL_GROUPS, POOL_GROUP_DIM), jnp.float32), jnp.cumsum(af, axis=1)], axis=1)
    t = jnp.arange(S)
    outs = []
    for g, w in enumerate(POOL_WINDOWS):
        left = w // 2
        right = w - 1 - left
        hi = jnp.minimum(t + right + 1, S)
        lo = jnp.maximum(t - left, 0)
        pg = prefix[:, :, g]
        win_sum = jnp.take(pg, hi, axis=1) - jnp.take(pg, lo, axis=1)
        cnt = (hi - lo).astype(jnp.float32)[None, :, None]
        outs.append(win_sum / cnt - af[:, :, g])
    m = jnp.stack(outs, axis=2).astype(a.dtype)
    y = jnp.einsum('bsgc,gcd->bsgd', m, pool_w).reshape(B, S, POOL_WIDTH)
    return y * pool_scale


def fourier_mixer(f, fourier_w):
    B, S, _ = f.shape
    f4 = f.reshape(B, S, N_FOURIER_GROUPS, FOURIER_GROUP_DIM).astype(jnp.float32)
    y = jnp.real(jnp.fft.fft2(f4, axes=(1, 3), norm='ortho'))
    y = y.astype(f.dtype).reshape(B, S, FOURIER_WIDTH)
    return y @ fourier_w


def diff_attention(q, k, v, lam, lam_init, head_norm):
    B, S = q.shape[0], q.shape[1]
    n_blk = S // Q_BLOCK
    scale = ATTN_HEAD_DIM ** -0.5
    slopes = alibi_slopes(ATTN_HEADS)
    kpos = jnp.arange(S, dtype=jnp.float32)
    qb = q.reshape(B, n_blk, Q_BLOCK, ATTN_HEADS, 2, ATTN_HEAD_DIM).transpose(1, 0, 2, 3, 4, 5)

    def one_block(args):
        q_blk, i = args
        qpos = (i * Q_BLOCK + jnp.arange(Q_BLOCK)).astype(jnp.float32)
        bias = -slopes[:, None, None] * jnp.abs(qpos[:, None] - kpos[None, :])
        s = jnp.einsum('bqhjd,bkhjd->bhjqk', q_blk, k).astype(jnp.float32) * scale + bias[None, :, None]
        p = jax.nn.softmax(s, axis=-1)
        attn = p[:, :, 0] - lam.astype(jnp.float32) * p[:, :, 1]
        return jnp.einsum('bhqk,bkhe->bqhe', attn.astype(v.dtype), v)

    o = lax.map(one_block, (qb, jnp.arange(n_blk)))
    o = o.transpose(1, 0, 2, 3, 4).reshape(B, S, ATTN_HEADS, ATTN_V_DIM)
    o = rmsnorm(o, head_norm.reshape(ATTN_HEADS, ATTN_V_DIM)) * (1.0 - lam_init)
    return o.reshape(B, S, ATTN_WIDTH)


def setup_inputs(seed: int = 0) -> dict:
    key = jax.random.key(seed)
    ks = jax.random.split(key, 24)
    f32 = jnp.float32

    def nrm(k, shape, fan_in):
        return jax.random.normal(k, shape, f32) * (fan_in ** -0.5)

    def gain(k, shape):
        return 1.0 + 0.05 * jax.random.normal(k, shape, f32)

    return {
        "x": jax.random.normal(ks[0], (BATCH, SEQ, D_MODEL), f32),
        "ffn1_norm": gain(ks[1], (DEPTH, D_MODEL)),
        "ffn1_w_gate": nrm(ks[2], (DEPTH, D_MODEL, D_FF), D_MODEL),
        "ffn1_w_up": nrm(ks[3], (DEPTH, D_MODEL, D_FF), D_MODEL),
        "ffn1_w_down": nrm(ks[4], (DEPTH, D_FF, D_MODEL), D_FF),
        "mix_norm": gain(ks[5], (DEPTH, D_MODEL)),
        "w_in": nrm(ks[6], (DEPTH, D_MODEL, IN_COLS), D_MODEL),
        "pool_w": nrm(ks[7], (DEPTH, N_POOL_GROUPS, POOL_GROUP_DIM, POOL_GROUP_DIM), POOL_GROUP_DIM),
        "pool_scale": gain(ks[8], (DEPTH, POOL_WIDTH)),
        "fourier_w": nrm(ks[9], (DEPTH, FOURIER_WIDTH, FOURIER_WIDTH), FOURIER_WIDTH),
        "lam_q1": 0.1 * jax.random.normal(ks[10], (DEPTH, ATTN_HEAD_DIM), f32),
        "lam_k1": 0.1 * jax.random.normal(ks[11], (DEPTH, ATTN_HEAD_DIM), f32),
        "lam_q2": 0.1 * jax.random.normal(ks[12], (DEPTH, ATTN_HEAD_DIM), f32),
        "lam_k2": 0.1 * jax.random.normal(ks[13], (DEPTH, ATTN_HEAD_DIM), f32),
        "attn_head_norm": gain(ks[14], (DEPTH, ATTN_WIDTH)),
        "w_out": nrm(ks[15], (DEPTH, D_MODEL, D_MODEL), D_MODEL),
        "ffn2_norm": gain(ks[16], (DEPTH, D_MODEL)),
        "ffn2_w_gate": nrm(ks[17], (DEPTH, D_MODEL, D_FF), D_MODEL),
        "ffn2_w_up": nrm(ks[18], (DEPTH, D_MODEL, D_FF), D_MODEL),
        "ffn2_w_down": nrm(ks[19], (DEPTH, D_FF, D_MODEL), D_FF),
        "final_norm": gain(ks[20], (D_MODEL,)),
    }


def reference(x, ffn1_norm, ffn1_w_gate, ffn1_w_up, ffn1_w_down, mix_norm, w_in, pool_w, pool_scale,
              fourier_w, lam_q1, lam_k1, lam_q2, lam_k2, attn_head_norm, w_out,
              ffn2_norm, ffn2_w_gate, ffn2_w_up, ffn2_w_down, final_norm):
    B, S, _ = x.shape
    c0 = POOL_WIDTH
    c1 = c0 + FOURIER_WIDTH
    c2 = c1 + ATTN_WIDTH
    c3 = c2 + ATTN_WIDTH
    for l in range(DEPTH):
        h = rmsnorm(x, ffn1_norm[l])
        x = x + 0.5 * swiglu(h, ffn1_w_gate[l], ffn1_w_up[l], ffn1_w_down[l])

        h = rmsnorm(x, mix_norm[l])
        p = h @ w_in[l]
        a = p[..., :c0]
        f = p[..., c0:c1]
        q = p[..., c1:c2].reshape(B, S, ATTN_HEADS, 2, ATTN_HEAD_DIM)
        k = p[..., c2:c3].reshape(B, S, ATTN_HEADS, 2, ATTN_HEAD_DIM)
        v = p[..., c3:].reshape(B, S, ATTN_HEADS, ATTN_V_DIM)

        lam_init = lambda_init_fn(l)
        lam = (jnp.exp(jnp.sum(lam_q1[l].astype(jnp.float32) * lam_k1[l].astype(jnp.float32)))
               - jnp.exp(jnp.sum(lam_q2[l].astype(jnp.float32) * lam_k2[l].astype(jnp.float32)))
               + lam_init)

        y_pool = pool_mixer(a, pool_w[l], pool_scale[l])
        y_four = fourier_mixer(f, fourier_w[l])
        y_attn = diff_attention(q, k, v, lam, lam_init, attn_head_norm[l]).astype(x.dtype)
        y = jnp.concatenate([y_pool, y_four, y_attn], axis=-1) @ w_out[l]
        x = x + y

        h = rmsnorm(x, ffn2_norm[l])
        x = x + 0.5 * swiglu(h, ffn2_w_gate[l], ffn2_w_up[l], ffn2_w_down[l])
    return rmsnorm(x, final_norm)
```

```cpp
#include <hip/hip_runtime.h>
#include <hip/hip_cooperative_groups.h>
#include <cstdio>
#include <cstdint>
namespace cg = cooperative_groups;
__device__ __forceinline__ int fresh_tid();
namespace pg8 {
#define PG8_LAS __attribute__((address_space(3)))
typedef unsigned short bf16_t;
typedef short bf16x8 __attribute__((ext_vector_type(8)));
typedef float f32x4 __attribute__((ext_vector_type(4)));
typedef unsigned u32x4 __attribute__((ext_vector_type(4)));
constexpr int BM = 256, BK = 64, HALF = 128, HTB = HALF * BK * 2  , STAGE_BYTES = 8 * HTB, NXCD = 8, WGM = 8;

__host__ __device__ __forceinline__ int lds_byte(int r, int c) { const int st = (r >> 4) * 2 + (c >> 5), rr = r & 15, cc = c & 31, ob = rr * 64 + cc * 2; return st * 1024 + (ob ^ (((ob >> 9) & 1) << 5)); }
__host__ __device__ __forceinline__ void stage_rc(int b, int& R, int& C) { const int st = b / 1024, sb = b % 1024, swz = sb ^ (((sb >> 9) & 1) << 5); R = (st >> 1) * 16 + swz / 64; C = (st & 1) * 32 + (swz % 64) / 2; }
__host__ __device__ __forceinline__ int perm32(int rho) { const int n = rho >> 4, i = rho & 15; return 8 * (i >> 2) + 4 * n + (i & 3); }

struct Unit { int pm, pn; };
struct Gemm { const bf16_t* A; const bf16_t* Bt; int M, N, K; };

struct StaticOrder {
    int nM, nN, nwg, G, c;
    __host__ __device__ void init(int M, int N, int G_, int c_) { nM = M / BM; nN = N / BM; nwg = nM * nN; G = G_; c = c_; }
    __host__ __device__ bool next(int i, Unit& u) const {
        const long L = (long)i * G + c; if (L >= nwg) return false;
        int wgid = (int)L; { const int q = nwg / NXCD, r = nwg % NXCD, xcd = wgid % NXCD, off = wgid / NXCD; wgid = (xcd < r ? xcd * (q + 1) : r * (q + 1) + (xcd - r) * q) + off; }
        const int nig = WGM * nN, gid = wgid / nig, fm = gid * WGM, gsz = (nM - fm) < WGM ? (nM - fm) : WGM;
        u.pm = fm + ((wgid % nig) % gsz); u.pn = (wgid % nig) / gsz; return true;
    }
    __device__ __forceinline__ void a_ready(const Unit&) const {}
    __device__ __forceinline__ void done(const Unit&) const {}
};
__device__ __forceinline__ unsigned cvt_pk_bf16(float lo, float hi) { unsigned r; asm volatile("v_cvt_pk_bf16_f32 %0, %1, %2" : "=v"(r) : "v"(lo), "v"(hi)); return r; }
template <class Epi, class Sched, bool ALIGN_EPI = false, bool SP2 = false>
__device__ __forceinline__ void gemm_phase(PG8_LAS unsigned char* lds, const Gemm g, const Sched& S, const Epi& E) {
    const int tid = fresh_tid(), wid = __builtin_amdgcn_readfirstlane(tid >> 6), lane = tid & 63, wr = wid >> 2, wc = wid & 3, fr = lane & 15, fq = lane >> 4;
    const int K = g.K, nt = K / BK;
    unsigned voffA[2], voffB[2];
#pragma unroll
    for (int i = 0; i < 2; ++i) { int R, C; stage_rc(tid * 16 + i * 8192, R, C); const int Rb = Epi::PERM ? ((R & ~31) + perm32(R & 31)) : R;
        voffA[i] = (unsigned)(R * K + C) * 2u; voffB[i] = (unsigned)(Rb * K + C) * 2u; }
    const size_t kstep = (size_t)(BK * 2);
    const size_t hstep = (size_t)HALF * K * 2;
    const size_t tstep = 2 * hstep;
    const unsigned ldsw = (unsigned)wid * 1024u;
    const int aoff = lds_byte(wr * 64 + fr, fq * 8), boff = lds_byte(wc * 32 + fr, fq * 8);
#define PG8_SA(b, h) (((b) * 2 + (h)) * HTB)
#define PG8_SB(b, h) ((4 + (b) * 2 + (h)) * HTB)
#define PG8_STAGE(bufoff, gbase, voff) do { _Pragma("unroll") for (int _i = 0; _i < 2; ++_i) \
        __builtin_amdgcn_global_load_lds((const unsigned*)((const char*)(gbase) + (voff)[_i]), (PG8_LAS unsigned*)(lds + (bufoff) + ldsw + _i * 8192), 16, 0, 0); } while (0)
#define PG8_LDA(dst, b, h) do { _Pragma("unroll") for (int m = 0; m < 4; ++m) _Pragma("unroll") for (int k = 0; k < 2; ++k) dst[m][k] = *(const PG8_LAS bf16x8*)(lds + PG8_SA(b, h) + aoff + m * 2048 + k * 1024); } while (0)
#define PG8_LDB(dst, b, h) do { _Pragma("unroll") for (int n = 0; n < 2; ++n) _Pragma("unroll") for (int k = 0; k < 2; ++k) dst[n][k] = *(const PG8_LAS bf16x8*)(lds + PG8_SB(b, h) + boff + n * 2048 + k * 1024); } while (0)
#define PG8_MMA(ai, bj, At, Bt) do { __builtin_amdgcn_s_setprio(1); _Pragma("unroll") for (int m = 0; m < 4; ++m) _Pragma("unroll") for (int n = 0; n < 2; ++n) _Pragma("unroll") for (int k = 0; k < 2; ++k) \
        acc[ai][bj][m][n] = __builtin_amdgcn_mfma_f32_16x16x32_bf16(Bt[n][k], At[m][k], acc[ai][bj][m][n], 0, 0, 0); __builtin_amdgcn_s_setprio(0); } while (0)
#define PG8_WAIT_V(n) asm volatile("s_waitcnt vmcnt(" #n ")" ::: "memory")
#define PG8_WAIT_L(n) asm volatile("s_waitcnt lgkmcnt(" #n ")" ::: "memory")
#define PG8_BAR __builtin_amdgcn_s_barrier()
#define PG8_SCHED __builtin_amdgcn_sched_barrier(0)
    Unit cur, nxt; int ui = 0;
    if (!S.next(0, cur)) return;
    f32x4 acc[2][2][4][2];
#pragma unroll
    for (int a = 0; a < 2; ++a)
#pragma unroll
        for (int b = 0; b < 2; ++b)
#pragma unroll
            for (int m = 0; m < 4; ++m)
#pragma unroll
                for (int n = 0; n < 2; ++n) acc[a][b][m][n] = (f32x4){0.f, 0.f, 0.f, 0.f};
    bf16x8 At[4][2], B0[2][2], B1[2][2];
    const char* cA = (const char*)g.A + (size_t)cur.pm * tstep; const char* cB = (const char*)g.Bt + (size_t)cur.pn * tstep;
    S.a_ready(cur);
    if constexpr (SP2) {
        PG8_STAGE(PG8_SB(0, 0), cB, voffB); PG8_STAGE(PG8_SB(0, 1), cB + hstep, voffB); PG8_STAGE(PG8_SA(0, 0), cA, voffA); PG8_STAGE(PG8_SA(0, 1), cA + hstep, voffA);
        if (wr == 1) PG8_BAR;
        PG8_WAIT_V(2); PG8_BAR;
        PG8_STAGE(PG8_SB(1, 0), cB + kstep, voffB); PG8_STAGE(PG8_SA(1, 0), cA + kstep, voffA); PG8_STAGE(PG8_SB(1, 1), cB + hstep + kstep, voffB);
        PG8_WAIT_V(6); PG8_BAR;
    } else {
        PG8_STAGE(PG8_SB(0, 0), cB, voffB); PG8_STAGE(PG8_SA(0, 0), cA, voffA); PG8_STAGE(PG8_SB(0, 1), cB + hstep, voffB); PG8_STAGE(PG8_SA(0, 1), cA + hstep, voffA);
        if (wr == 1) PG8_BAR;
        PG8_WAIT_V(4); PG8_BAR;
        PG8_STAGE(PG8_SB(1, 0), cB + kstep, voffB); PG8_STAGE(PG8_SA(1, 0), cA + kstep, voffA); PG8_STAGE(PG8_SB(1, 1), cB + hstep + kstep, voffB);
        PG8_WAIT_V(6); PG8_BAR;
    }
    for (;;) {
        const bool has_next = S.next(ui + 1, nxt);
        const char* nA = has_next ? (const char*)g.A + (size_t)nxt.pm * tstep : cA; const char* nB = has_next ? (const char*)g.Bt + (size_t)nxt.pn * tstep : cB;
        for (int t = 0; t < nt; t += 2) {
            const bool last = (t == nt - 2);
            const char* a1 = cA + (size_t)(t + 1) * kstep;
            const char* a2 = last ? nA : cA + (size_t)(t + 2) * kstep; const char* b2 = last ? nB : cB + (size_t)(t + 2) * kstep;
            const char* a3 = a2 + kstep; const char* b3 = b2 + kstep;
            if (last && has_next) S.a_ready(nxt);
            if constexpr (SP2) {
            PG8_LDB(B0, 0, 0); PG8_LDB(B1, 0, 1); PG8_SCHED; PG8_LDA(At, 0, 0); PG8_STAGE(PG8_SA(1, 1), a1 + hstep, voffA);
            PG8_WAIT_V(8); PG8_WAIT_L(0); PG8_BAR; PG8_MMA(0, 0, At, B0); PG8_MMA(0, 1, At, B1); PG8_BAR; PG8_SCHED;
            PG8_LDA(At, 0, 1); PG8_STAGE(PG8_SB(0, 0), b2, voffB); PG8_STAGE(PG8_SB(0, 1), b2 + hstep, voffB); PG8_STAGE(PG8_SA(0, 0), a2, voffA);
            PG8_WAIT_V(8); PG8_WAIT_L(0); PG8_BAR; PG8_MMA(1, 0, At, B0); PG8_MMA(1, 1, At, B1); PG8_BAR; PG8_SCHED;
            PG8_LDB(B0, 1, 0); PG8_LDB(B1, 1, 1); PG8_SCHED; PG8_LDA(At, 1, 0); PG8_STAGE(PG8_SA(0, 1), a2 + hstep, voffA);
            PG8_WAIT_V(8); PG8_WAIT_L(0); PG8_BAR; PG8_MMA(0, 0, At, B0); PG8_MMA(0, 1, At, B1); PG8_BAR; PG8_SCHED;
            PG8_LDA(At, 1, 1); PG8_STAGE(PG8_SB(1, 0), b3, voffB); PG8_STAGE(PG8_SB(1, 1), b3 + hstep, voffB); PG8_STAGE(PG8_SA(1, 0), a3, voffA);
            PG8_WAIT_V(8); PG8_WAIT_L(0); PG8_BAR; PG8_MMA(1, 0, At, B0); PG8_MMA(1, 1, At, B1); PG8_BAR; PG8_SCHED;
            } else {
            PG8_LDB(B0, 0, 0); PG8_SCHED; PG8_LDA(At, 0, 0); PG8_STAGE(PG8_SA(1, 1), a1 + hstep, voffA);
            PG8_WAIT_L(8); PG8_BAR; PG8_WAIT_L(0); PG8_MMA(0, 0, At, B0); PG8_BAR; PG8_SCHED;
            PG8_LDB(B1, 0, 1); PG8_STAGE(PG8_SB(0, 0), b2, voffB);
            PG8_BAR; PG8_WAIT_L(0); PG8_MMA(0, 1, At, B1); PG8_BAR;
            PG8_LDA(At, 0, 1); PG8_STAGE(PG8_SA(0, 0), a2, voffA);
            PG8_BAR; PG8_WAIT_L(0); PG8_MMA(1, 0, At, B0); PG8_BAR; PG8_SCHED;
            PG8_STAGE(PG8_SB(0, 1), b2 + hstep, voffB);
            PG8_WAIT_V(6); PG8_BAR; PG8_MMA(1, 1, At, B1); PG8_BAR;
            PG8_LDB(B0, 1, 0); PG8_SCHED; PG8_LDA(At, 1, 0); PG8_STAGE(PG8_SA(0, 1), a2 + hstep, voffA);
            PG8_WAIT_L(8); PG8_BAR; PG8_WAIT_L(0); PG8_MMA(0, 0, At, B0); PG8_BAR; PG8_SCHED;
            PG8_LDB(B1, 1, 1); PG8_STAGE(PG8_SB(1, 0), b3, voffB);
            PG8_BAR; PG8_WAIT_L(0); PG8_MMA(0, 1, At, B1); PG8_BAR;
            PG8_LDA(At, 1, 1); PG8_STAGE(PG8_SA(1, 0), a3, voffA);
            PG8_BAR; PG8_WAIT_L(0); PG8_MMA(1, 0, At, B0); PG8_BAR; PG8_SCHED;
            PG8_STAGE(PG8_SB(1, 1), b3 + hstep, voffB);
            PG8_WAIT_V(6); PG8_BAR; PG8_MMA(1, 1, At, B1); PG8_BAR;
            }
        }
        if constexpr (ALIGN_EPI) { if (wr == 0) PG8_BAR; }
        if constexpr (!Epi::AFTER_DRAIN) { E(acc, cur, wr, wc, fr, fq); S.done(cur); }
        if (!has_next) break;
#pragma unroll
        for (int a = 0; a < 2; ++a)
#pragma unroll
            for (int b = 0; b < 2; ++b)
#pragma unroll
                for (int m = 0; m < 4; ++m)
#pragma unroll
                    for (int n = 0; n < 2; ++n) acc[a][b][m][n] = (f32x4){0.f, 0.f, 0.f, 0.f};
        cur = nxt; cA = nA; cB = nB; ++ui;
        if constexpr (ALIGN_EPI) { if (wr == 1) PG8_BAR; }
    }
    PG8_WAIT_V(0);
    if constexpr (!ALIGN_EPI) { if (wr == 0) PG8_BAR; }
    PG8_BAR;
    if constexpr (Epi::AFTER_DRAIN) { E.fused(acc, cur, wr, wc, fr, fq, lds, wid, lane); S.done(cur); }
#undef PG8_SA
#undef PG8_SB
#undef PG8_STAGE
#undef PG8_LDA
#undef PG8_LDB
#undef PG8_MMA
#undef PG8_WAIT_V
#undef PG8_WAIT_L
#undef PG8_BAR
#undef PG8_SCHED
}
}

#define LAS __attribute__((address_space(3)))
typedef unsigned short bf16_t;
typedef short bf16x8 __attribute__((ext_vector_type(8)));
typedef short s16x4 __attribute__((ext_vector_type(4)));
typedef short v4i16_t __attribute__((ext_vector_type(4)));
typedef float f32x2 __attribute__((ext_vector_type(2)));
typedef float f32x4 __attribute__((ext_vector_type(4)));
typedef float f32x16 __attribute__((ext_vector_type(16)));
typedef unsigned u32x2 __attribute__((ext_vector_type(2)));
typedef unsigned u32x4 __attribute__((ext_vector_type(4)));
typedef __bf16 bf16x2_t __attribute__((ext_vector_type(2)));

#ifndef PROBE_MASK
#define PROBE_MASK 0
#endif
#ifndef MK_MULTI
#define MK_MULTI 0
#endif

constexpr int MTOK = 16384, DM = 1024, DFF = 2816, SEQ = 8192, NLAYER = 4;
constexpr int PW = 512;
constexpr int YW = 1280;
constexpr float EPS = 1e-6f;
constexpr float LOG2E = 1.4426950408889634f;
constexpr float QSCALE = 0.125f * LOG2E;
constexpr size_t MiB = (size_t)1 << 20;
constexpr size_t WS_MISC = 0, WS_TAB = 2 * MiB, WS_WFWO = 3 * MiB, WS_W = 4 * MiB;
constexpr size_t WS_XF = 48 * MiB, WS_XB = 112 * MiB, WS_ACT = 144 * MiB, WS_P = 144 * MiB, WS_YCAT = 208 * MiB, WS_GP = 248 * MiB, WS_SS = 264 * MiB, WS_QC = 160 * MiB, WS_KC = 176 * MiB, WS_VC = 192 * MiB, WS_W1 = 277 * MiB, WS_END = 317 * MiB;
constexpr size_t W_GU1 = 0, W_D1 = 11534336, W_GU2 = 17301504, W_D2 = 28835840, W_IN = 34603008, W_O = 38797312;
constexpr size_t TB_64C = 0, TB_64S = 8192, TB_128C = 16384, TB_128S = 49152, TB_TWC = 81920, TB_TWS = 114688, TB_64FC = 147456, TB_64FS = 163840;
constexpr int LDS_BYTES = 139264;
constexpr int NPHASE = 1 + 8 * NLAYER + 1;
constexpr int CONV_TILE_CHUNKS = 1216, CONV_CHUNKS = CONV_TILE_CHUNKS + 128;

struct Args { const float* in[21]; float* out; unsigned char* ws; int ph_lo, ph_hi, coop, pad; };
typedef const __attribute__((address_space(4))) Args CArgs;

__device__ __forceinline__ unsigned pk2(float lo, float hi) { f32x2 v = {lo, hi}; bf16x2_t b = __builtin_convertvector(v, bf16x2_t); return __builtin_bit_cast(unsigned, b); }
__device__ __forceinline__ bf16_t bf1(float x) { return (bf16_t)(pk2(x, 0.f) & 0xffffu); }
__device__ __forceinline__ float wave_sum(float v) {
#pragma unroll
    for (int o = 1; o < 64; o <<= 1) v += __shfl_xor(v, o);
    return v;
}
__device__ __forceinline__ int fresh_tid() { int t; asm volatile("v_mov_b32 %0, %1" : "=v"(t) : "v"((int)threadIdx.x)); return t; }
__device__ __forceinline__ unsigned char* wbuf(unsigned char* ws, int l) { return ws + ((l & 1) ? WS_W1 : WS_W); }
__device__ __forceinline__ int crow(int r, int hi) { return (r & 3) + 8 * (r >> 2) + 4 * hi; }
__device__ __forceinline__ s16x4 vtr(const LAS unsigned char* p) { return __builtin_bit_cast(s16x4, __builtin_amdgcn_ds_read_tr16_b64_v4i16((LAS v4i16_t*)p)); }
__device__ __forceinline__ bf16x8 cat8(s16x4 lo, s16x4 hi) { return __builtin_shufflevector(lo, hi, 0, 1, 2, 3, 4, 5, 6, 7); }
#define MFMA32(a, b, c) __builtin_amdgcn_mfma_f32_32x32x16_bf16((a), (b), (c), 0, 0, 0)

__device__ __forceinline__ float row_rs(const float* ss, int row) {
    const f32x4* p = (const f32x4*)(ss + (size_t)row * 16); const f32x4 a = p[0], b = p[1], c = p[2], d = p[3];
    const float s = (((a.x + a.y) + (a.z + a.w)) + ((b.x + b.y) + (b.z + b.w))) + (((c.x + c.y) + (c.z + c.w)) + ((d.x + d.y) + (d.z + d.w)));
    return rsqrtf(s * (1.0f / DM) + EPS);
}
__device__ __forceinline__ void rows_rs8(const float* ss, int row0, int fq, float (&r)[8]) {
    f32x4 pv[8];
#pragma unroll
    for (int i = 0; i < 8; ++i) pv[i] = ((const f32x4*)(ss + (size_t)(row0 + (i >> 2) * 128 + (i & 3) * 16) * 16))[fq];
#pragma unroll
    for (int i = 0; i < 8; ++i) {
        float q = (pv[i].x + pv[i].y) + (pv[i].z + pv[i].w);
        q += __shfl_xor(q, 16); q += __shfl_xor(q, 32);
        r[i] = rsqrtf(q * (1.0f / DM) + EPS);
    }
}
struct EpiSwiGLU {
    static constexpr bool PERM = true, AFTER_DRAIN = false;
    bf16_t* act; const float* ss;
    __device__ __forceinline__ void operator()(const pg8::f32x4 (&acc)[2][2][4][2], const pg8::Unit& u, int wr, int wc, int fr, int fq) const {
        const int row0 = u.pm * 256 + wr * 64 + fr, col0 = u.pn * 128 + wc * 32 + 8 * fq;
        float rs[8]; rows_rs8(ss, row0, fq, rs);
#pragma unroll
        for (int ai = 0; ai < 2; ++ai)
#pragma unroll
            for (int m = 0; m < 4; ++m) {
                const int row = row0 + ai * 128 + m * 16;
                const float r = rs[ai * 4 + m];
                float o[8];
#pragma unroll
                for (int n = 0; n < 2; ++n)
#pragma unroll
                    for (int i = 0; i < 4; ++i) {
                        const float g = acc[ai][0][m][n][i] * r, up = acc[ai][1][m][n][i] * r;
                        const float sg = g * __builtin_amdgcn_rcpf(1.0f + __builtin_amdgcn_exp2f(-g * LOG2E));
                        o[4 * n + i] = sg * up;
                    }
                u32x4 w; w.x = pk2(o[0], o[1]); w.y = pk2(o[2], o[3]); w.z = pk2(o[4], o[5]); w.w = pk2(o[6], o[7]);
                *(u32x4*)(act + (size_t)row * DFF + col0) = w;
            }
    }
};
struct EpiResid {
    static constexpr bool PERM = true, AFTER_DRAIN = false;
    const float* xin; bf16_t* xl; bf16_t* xb; float* ss_out; float scale;
    __device__ __forceinline__ void operator()(const pg8::f32x4 (&acc)[2][2][4][2], const pg8::Unit& u, int wr, int wc, int fr, int fq) const {
        const int row0 = u.pm * 256 + wr * 64 + fr, col0 = u.pn * 256 + wc * 32 + 8 * fq;
#pragma unroll
        for (int ai = 0; ai < 2; ++ai)
#pragma unroll
            for (int m = 0; m < 4; ++m) {
                const int row = row0 + ai * 128 + m * 16;
                float sq = 0.f;
#pragma unroll
                for (int bj = 0; bj < 2; ++bj) {
                    const size_t off = (size_t)row * DM + col0 + bj * 128;
                    f32x4 x0, x1;
                    if (xin) { x0 = *(const f32x4*)(xin + off); x1 = *(const f32x4*)(xin + off + 4); }
                    else {
                        const u32x4 h = *(const u32x4*)(xb + off), lo = *(const u32x4*)(xl + off);
                        x0 = (f32x4){__uint_as_float(h.x << 16) + __uint_as_float(lo.x << 16), __uint_as_float(h.x & 0xffff0000u) + __uint_as_float(lo.x & 0xffff0000u),
                                     __uint_as_float(h.y << 16) + __uint_as_float(lo.y << 16), __uint_as_float(h.y & 0xffff0000u) + __uint_as_float(lo.y & 0xffff0000u)};
                        x1 = (f32x4){__uint_as_float(h.z << 16) + __uint_as_float(lo.z << 16), __uint_as_float(h.z & 0xffff0000u) + __uint_as_float(lo.z & 0xffff0000u),
                                     __uint_as_float(h.w << 16) + __uint_as_float(lo.w << 16), __uint_as_float(h.w & 0xffff0000u) + __uint_as_float(lo.w & 0xffff0000u)};
                    }
                    x0 = x0 + acc[ai][bj][m][0] * scale; x1 = x1 + acc[ai][bj][m][1] * scale;
                    sq += (x0.x * x0.x + x0.y * x0.y) + (x0.z * x0.z + x0.w * x0.w) + (x1.x * x1.x + x1.y * x1.y) + (x1.z * x1.z + x1.w * x1.w);
                    u32x4 w; w.x = pk2(x0.x, x0.y); w.y = pk2(x0.z, x0.w); w.z = pk2(x1.x, x1.y); w.w = pk2(x1.z, x1.w);
                    u32x4 v;
                    v.x = pk2(x0.x - __uint_as_float(w.x << 16), x0.y - __uint_as_float(w.x & 0xffff0000u)); v.y = pk2(x0.z - __uint_as_float(w.y << 16), x0.w - __uint_as_float(w.y & 0xffff0000u));
                    v.z = pk2(x1.x - __uint_as_float(w.z << 16), x1.y - __uint_as_float(w.z & 0xffff0000u)); v.w = pk2(x1.z - __uint_as_float(w.w << 16), x1.w - __uint_as_float(w.w & 0xffff0000u));
                    *(u32x4*)(xb + off) = w; *(u32x4*)(xl + off) = v;
                }
                sq += __shfl_xor(sq, 16); sq += __shfl_xor(sq, 32);
                if (fq == 0) ss_out[(size_t)row * 16 + u.pn * 4 + wc] = sq;
            }
    }
};
struct EpiWin {
    static constexpr bool PERM = true, AFTER_DRAIN = false;
    bf16_t* P; bf16_t* QKV; const float* ss;
    __device__ __forceinline__ void operator()(const pg8::f32x4 (&acc)[2][2][4][2], const pg8::Unit& u, int wr, int wc, int fr, int fq) const {
        const int row0 = u.pm * 256 + wr * 64 + fr, cw = wc * 32 + 8 * fq;
        const float qs = (u.pn == 2 || u.pn == 3) ? QSCALE : 1.0f;
        float rs[8]; rows_rs8(ss, row0, fq, rs);
#pragma unroll
        for (int ai = 0; ai < 2; ++ai)
#pragma unroll
            for (int m = 0; m < 4; ++m) {
                const int row = row0 + ai * 128 + m * 16;
                const float r = rs[ai * 4 + m] * qs;
#pragma unroll
                for (int bj = 0; bj < 2; ++bj) {
                    const f32x4 v0 = acc[ai][bj][m][0] * r, v1 = acc[ai][bj][m][1] * r;
                    u32x4 w; w.x = pk2(v0.x, v0.y); w.y = pk2(v0.z, v0.w); w.z = pk2(v1.x, v1.y); w.w = pk2(v1.z, v1.w);
                    if (u.pn < 2) *(u32x4*)(P + (size_t)row * PW + u.pn * 256 + bj * 128 + cw) = w;
                    else { const int sect = (u.pn - 2) >> 1, h = ((u.pn & 1) << 1) + bj;
                        *(u32x4*)(QKV + (size_t)sect * (8u << 20) + ((size_t)(((row >> 13) * 4 + h) * SEQ + (row & (SEQ - 1)))) * 128 + cw) = w; }
                }
            }
    }
};

__device__ __forceinline__ void conv_chunk(CArgs* a, int l, int chunk, LAS unsigned char* lds);
__device__ __forceinline__ void phase_p0(CArgs* a, LAS unsigned char* lds) {
    const int tid = fresh_tid(), lane = tid & 63, wave = tid >> 6;
    unsigned char* ws = a->ws;
    float* xf = (float*)(ws + WS_XF); bf16_t* xb = (bf16_t*)(ws + WS_XB); float* ss = (float*)(ws + WS_SS);
    const float* x = a->in[0];
    for (int row0 = blockIdx.x * 8 + wave; row0 < MTOK; row0 += gridDim.x * 16) {
        const int row1 = row0 + gridDim.x * 8; const bool has1 = row1 < MTOK; const int r1 = has1 ? row1 : row0;
        const f32x4* xr0 = (const f32x4*)(x + (size_t)row0 * DM) + lane; const f32x4* xr1 = (const f32x4*)(x + (size_t)r1 * DM) + lane;
        f32x4 v0[4], v1[4]; float s0 = 0.f, s1 = 0.f;
#pragma unroll
        for (int j = 0; j < 4; ++j) { v0[j] = xr0[64 * j]; v1[j] = xr1[64 * j]; }
#pragma unroll
        for (int j = 0; j < 4; ++j) { s0 += (v0[j].x * v0[j].x + v0[j].y * v0[j].y) + (v0[j].z * v0[j].z + v0[j].w * v0[j].w); s1 += (v1[j].x * v1[j].x + v1[j].y * v1[j].y) + (v1[j].z * v1[j].z + v1[j].w * v1[j].w); }
        s0 = wave_sum(s0); s1 = wave_sum(s1);
        u32x2* bo0 = (u32x2*)(xb + (size_t)row0 * DM) + lane; u32x2* bo1 = (u32x2*)(xb + (size_t)r1 * DM) + lane;
#pragma unroll
        for (int j = 0; j < 4; ++j) { u32x2 w; w.x = pk2(v0[j].x, v0[j].y); w.y = pk2(v0[j].z, v0[j].w); bo0[64 * j] = w; }
        if (lane < 16) ss[(size_t)row0 * 16 + lane] = (lane == 0) ? s0 : 0.f;
        if (has1) {
#pragma unroll
            for (int j = 0; j < 4; ++j) { u32x2 w; w.x = pk2(v1[j].x, v1[j].y); w.y = pk2(v1[j].z, v1[j].w); bo1[64 * j] = w; }
            if (lane < 16) ss[(size_t)row1 * 16 + lane] = (lane == 0) ? s1 : 0.f;
        }
    }
    const int gtid = blockIdx.x * 512 + tid, NT = gridDim.x * 512;
    unsigned char* tb = ws + WS_TAB;
    for (int i = gtid; i < 4096; i += NT) {
        const int k = i >> 6, s = i & 63, idx = (k * s) & 63;
        const float c = cospif((float)idx * (2.0f / 64.0f)), sn = sinpif((float)idx * (2.0f / 64.0f));
        ((bf16_t*)(tb + TB_64C))[i] = bf1(c); ((bf16_t*)(tb + TB_64S))[i] = bf1(sn);
        ((float*)(tb + TB_64FC))[i] = c; ((float*)(tb + TB_64FS))[i] = sn;
    }
    for (int i = gtid; i < 16384; i += NT) {
        const int k = i >> 7, s = i & 127, idx = (k * s) & 127;
        ((bf16_t*)(tb + TB_128C))[i] = bf1(cospif((float)idx * (2.0f / 128.0f))); ((bf16_t*)(tb + TB_128S))[i] = bf1(sinpif((float)idx * (2.0f / 128.0f)));
    }
    for (int i = gtid; i < 8192; i += NT) {
        const int s2 = i >> 6, k1 = i & 63, idx = s2 * k1;
        ((float*)(tb + TB_TWC))[i] = cospif((float)idx * (2.0f / 8192.0f)); ((float*)(tb + TB_TWS))[i] = sinpif((float)idx * (2.0f / 8192.0f));
    }
    for (int chunk = blockIdx.x; chunk < CONV_CHUNKS; chunk += gridDim.x) conv_chunk(a, 0, chunk, lds);
    if (blockIdx.x == 0 && tid < 8) ((unsigned*)(ws + WS_MISC + 256))[tid] = 0u;
    if (blockIdx.x == 0 && wave == 0) {
        for (int l = 0; l < NLAYER; ++l) {
            const float p1 = a->in[10][l * 64 + lane] * a->in[11][l * 64 + lane], p2 = a->in[12][l * 64 + lane] * a->in[13][l * 64 + lane];
            const float s1 = wave_sum(p1), s2 = wave_sum(p2);
            if (lane == 0) ((float*)(ws + WS_MISC))[l] = expf(s1) - expf(s2) + (0.8f - 0.6f * expf(-0.3f * (float)l));
        }
    }
}

__device__ __forceinline__ void conv_wtile(const float* src, int ld_src, int k0, int n0, const float* gain, bf16_t* dst, int ld_dst, int kofs, int nmode, LAS float* scr, int lane) {
    float v[32];
    const float* sp0 = src + (size_t)(k0 + (lane >> 5)) * ld_src + n0 + (lane & 31);
#pragma unroll
    for (int i = 0; i < 32; ++i) v[i] = sp0[(size_t)(2 * i) * ld_src];
#pragma unroll
    for (int i = 0; i < 32; ++i) scr[(2 * i + (lane >> 5)) * 33 + (lane & 31)] = v[i];
    asm volatile("s_waitcnt lgkmcnt(0)" ::: "memory");
    const int c = lane & 7;
    f32x4 g0 = {1.f, 1.f, 1.f, 1.f}, g1 = {1.f, 1.f, 1.f, 1.f};
    if (gain) { g0 = *(const f32x4*)(gain + k0 + 8 * c); g1 = *(const f32x4*)(gain + k0 + 8 * c + 4); }
#pragma unroll
    for (int j = 0; j < 4; ++j) {
        const int nl = (lane >> 3) + 8 * j, n = n0 + nl;
        const int np = (nmode == 0) ? n : (256 * (n >> 7) + (n & 127) + (nmode == 2 ? 128 : 0));
        const LAS float* sp = scr + (8 * c) * 33 + nl;
        u32x4 o; o.x = pk2(sp[0] * g0.x, sp[33] * g0.y); o.y = pk2(sp[2 * 33] * g0.z, sp[3 * 33] * g0.w); o.z = pk2(sp[4 * 33] * g1.x, sp[5 * 33] * g1.y); o.w = pk2(sp[6 * 33] * g1.z, sp[7 * 33] * g1.w);
        *(u32x4*)(dst + (size_t)np * ld_dst + kofs + k0 + 8 * c) = o;
    }
    asm volatile("s_waitcnt lgkmcnt(0)" ::: "memory");
}
__device__ __forceinline__ void conv_chunk(CArgs* a, int l, int chunk, LAS unsigned char* lds) {
    const int tid = fresh_tid(), lane = tid & 63, wave = tid >> 6;
    if (chunk < CONV_TILE_CHUNKS) {
        LAS float* scr = (LAS float*)(lds + wave * 8448);
        unsigned char* wb = wbuf(a->ws, l);
        const size_t FW = (size_t)DM * DFF;
        const int it = chunk * 8 + wave;
        if (it < 8448) {
            const int f = it / 4224, r = it % 4224;
            const float* gn = a->in[f ? 16 : 1] + l * DM;
            if (r < 2816) {
                const int up = r / 1408, t = r % 1408, kt = t / 88, nt = t % 88;
                const float* src = a->in[f ? (up ? 18 : 17) : (up ? 3 : 2)] + (size_t)l * FW;
                conv_wtile(src, DFF, kt * 64, nt * 32, gn, (bf16_t*)(wb + (f ? W_GU2 : W_GU1)), DM, 0, up ? 2 : 1, scr, lane);
            } else {
                const int t = r - 2816, kt = t / 32, nt = t % 32;
                const float* src = a->in[f ? 19 : 4] + (size_t)l * FW;
                conv_wtile(src, DM, kt * 64, nt * 32, nullptr, (bf16_t*)(wb + (f ? W_D2 : W_D1)), DFF, 0, 0, scr, lane);
            }
        } else if (it < 9472) {
            const int t = it - 8448, kt = t / 64, nt = t % 64;
            conv_wtile(a->in[6] + (size_t)l * DM * 2048, 2048, kt * 64, nt * 32, a->in[5] + l * DM, (bf16_t*)(wb + W_IN), DM, 0, 0, scr, lane);
        } else {
            const int t = it - 9472, kt = t / 32, nt = t % 32;
            conv_wtile(a->in[15] + (size_t)l * DM * DM + (size_t)512 * DM, DM, kt * 64, nt * 32, nullptr, (bf16_t*)(wb + W_O), YW, 768, 0, scr, lane);
        }
    } else {
        const float* fw = a->in[9] + (size_t)l * 256 * 256; const float* wo = a->in[15] + (size_t)l * DM * DM + (size_t)256 * DM;
        float* wfwo = (float*)(a->ws + WS_WFWO);
        const int item = __builtin_amdgcn_readfirstlane((chunk - CONV_TILE_CHUNKS) * 8 + wave), rb = item >> 8, n0 = (item & 255) * 4, r = rb * 64 + lane;
        float acc0 = 0.f, acc1 = 0.f, acc2 = 0.f, acc3 = 0.f;
#pragma unroll 1
        for (int cc = 0; cc < 4; ++cc) {
            f32x4 av[16];
#pragma unroll
            for (int i = 0; i < 16; ++i) av[i] = *(const f32x4*)(fw + (size_t)r * 256 + cc * 64 + 4 * i);
            const float* B = wo + (size_t)(cc * 64) * DM + n0;
#pragma unroll
            for (int i = 0; i < 16; ++i)
#pragma unroll
                for (int e = 0; e < 4; ++e) {
                    const f32x4 bv = *(const f32x4*)(B + (size_t)(4 * i + e) * DM);
                    acc0 = fmaf(av[i][e], bv.x, acc0); acc1 = fmaf(av[i][e], bv.y, acc1); acc2 = fmaf(av[i][e], bv.z, acc2); acc3 = fmaf(av[i][e], bv.w, acc3);
                }
        }
        *(f32x4*)(wfwo + (size_t)r * DM + n0) = (f32x4){acc0, acc1, acc2, acc3};
    }
}
__device__ __forceinline__ void fold_wout(CArgs* a, int l) {
    const int tid = fresh_tid(), lane = tid & 63, wave = tid >> 6;
    const float* pw = a->in[7] + (size_t)l * 4 * 64 * 64; const float* ps = a->in[8] + l * 256; const float* wo = a->in[15] + (size_t)l * DM * DM;
    const float* wfwo = (const float*)(a->ws + WS_WFWO);
    const float* fc = (const float*)(a->ws + WS_TAB + TB_64FC); const float* fs = (const float*)(a->ws + WS_TAB + TB_64FS);
    bf16_t* wot = (bf16_t*)(wbuf(a->ws, l) + W_O);
    for (int item = __builtin_amdgcn_readfirstlane(blockIdx.x * 8 + wave); item < 3072; item += gridDim.x * 8) {
        const int sec = item >> 10, g = (item >> 8) & 3, n0 = (item & 255) * 4;
        const float* arow = (sec == 0) ? pw + (g * 64 + lane) * 64 : ((sec == 1) ? fc + lane * 64 : fs + lane * 64);
        const float* B = ((sec == 0) ? wo : wfwo) + (size_t)(g * 64) * DM + n0;
        float acc0 = 0.f, acc1 = 0.f, acc2 = 0.f, acc3 = 0.f;
#pragma unroll 4
        for (int d4 = 0; d4 < 16; ++d4) {
            f32x4 av = *(const f32x4*)(arow + 4 * d4);
            if (sec == 0) av = av * *(const f32x4*)(ps + g * 64 + 4 * d4);
#pragma unroll
            for (int e = 0; e < 4; ++e) {
                const f32x4 bv = *(const f32x4*)(B + (size_t)(4 * d4 + e) * DM);
                acc0 = fmaf(av[e], bv.x, acc0); acc1 = fmaf(av[e], bv.y, acc1); acc2 = fmaf(av[e], bv.z, acc2); acc3 = fmaf(av[e], bv.w, acc3);
            }
        }
        const float sc = (sec == 0) ? 1.0f : ((sec == 1) ? 0.125f : -0.125f);
        bf16_t* op = wot + (size_t)n0 * YW + sec * 256 + g * 64 + lane;
        op[0] = bf1(acc0 * sc); op[YW] = bf1(acc1 * sc); op[2 * YW] = bf1(acc2 * sc); op[3 * YW] = bf1(acc3 * sc);
    }
}

__device__ __forceinline__ void pool_unit(const bf16_t* P, bf16_t* ycat, int unit) {
    const int tid = fresh_tid(), chunk = tid & 31, trow = tid >> 5, g = chunk >> 3, w = 2 << g, left = w >> 1, right = w - 1 - left;
#pragma unroll 1
    for (int i = 0; i < 4; ++i) {
        const int t = unit * 64 + trow + 16 * i, b = t >> 13, s = t & (SEQ - 1);
        const int lo = max(s - left, 0), hi = min(s + right + 1, SEQ);
        u32x4 v[16];
#pragma unroll
        for (int j = 0; j < 16; ++j) { const int p = min(max(s - 8 + j, 0), SEQ - 1); v[j] = *(const u32x4*)(P + (size_t)(b * SEQ + p) * PW + chunk * 8); }
        float acc[8];
#pragma unroll
        for (int e = 0; e < 8; ++e) acc[e] = 0.f;
#pragma unroll
        for (int j = 0; j < 16; ++j) {
            const int p = s - 8 + j; const float wgt = (p >= lo && p < hi) ? 1.0f : 0.0f;
            acc[0] = fmaf(wgt, __uint_as_float(v[j].x << 16), acc[0]); acc[1] = fmaf(wgt, __uint_as_float(v[j].x & 0xffff0000u), acc[1]);
            acc[2] = fmaf(wgt, __uint_as_float(v[j].y << 16), acc[2]); acc[3] = fmaf(wgt, __uint_as_float(v[j].y & 0xffff0000u), acc[3]);
            acc[4] = fmaf(wgt, __uint_as_float(v[j].z << 16), acc[4]); acc[5] = fmaf(wgt, __uint_as_float(v[j].z & 0xffff0000u), acc[5]);
            acc[6] = fmaf(wgt, __uint_as_float(v[j].w << 16), acc[6]); acc[7] = fmaf(wgt, __uint_as_float(v[j].w & 0xffff0000u), acc[7]);
        }
        const u32x4 c = v[8];
        const float ic = 1.0f / (float)(hi - lo);
        u32x4 o;
        o.x = pk2(acc[0] * ic - __uint_as_float(c.x << 16), acc[1] * ic - __uint_as_float(c.x & 0xffff0000u));
        o.y = pk2(acc[2] * ic - __uint_as_float(c.y << 16), acc[3] * ic - __uint_as_float(c.y & 0xffff0000u));
        o.z = pk2(acc[4] * ic - __uint_as_float(c.z << 16), acc[5] * ic - __uint_as_float(c.z & 0xffff0000u));
        o.w = pk2(acc[6] * ic - __uint_as_float(c.w << 16), acc[7] * ic - __uint_as_float(c.w & 0xffff0000u));
        *(u32x4*)(ycat + (size_t)t * YW + chunk * 8) = o;
    }
}

__device__ __forceinline__ void fa_unit(LAS unsigned char* lds, const bf16_t* P, bf16_t* GP, const unsigned char* tb, int b, int s2) {
    const int tid = fresh_tid(), lane = tid & 63, r32 = lane & 31, hi = lane >> 5, wid = __builtin_amdgcn_readfirstlane(tid >> 6);
#pragma unroll
    for (int i = 0; i < 4; ++i) {
        const int idx = tid + 512 * i, s1 = idx >> 5, ch = idx & 31;
        const u32x4 v = *(const u32x4*)(P + (size_t)(b * SEQ + 128 * s1 + s2) * PW + 256 + ch * 8);
        *(LAS u32x4*)(lds + (ch >> 2) * 4096 + s1 * 64 + (ch & 3) * 16) = v;
    }
    __syncthreads();
    const int i16 = lane & 15, q = i16 >> 2, p = i16 & 3, blk = (lane >> 4) & 1;
    const LAS unsigned char* bp = lds + wid * 4096 + (8 * hi + q) * 64 + blk * 32 + p * 8;
    bf16x8 bfr[4];
#pragma unroll
    for (int s = 0; s < 4; ++s) bfr[s] = cat8(vtr(bp + s * 1024), vtr(bp + s * 1024 + 256));
    const bf16_t* T64c = (const bf16_t*)(tb + TB_64C); const bf16_t* T64s = (const bf16_t*)(tb + TB_64S);
    const float* twc = (const float*)(tb + TB_TWC) + s2 * 64; const float* tws = (const float*)(tb + TB_TWS) + s2 * 64;
#pragma unroll
    for (int mt = 0; mt < 2; ++mt) {
        f32x16 gr, gs;
#pragma unroll
        for (int r = 0; r < 16; ++r) { gr[r] = 0.f; gs[r] = 0.f; }
#pragma unroll
        for (int s = 0; s < 4; ++s) {
            const bf16x8 ac = *(const bf16x8*)(T64c + (32 * mt + r32) * 64 + 16 * s + 8 * hi);
            const bf16x8 as = *(const bf16x8*)(T64s + (32 * mt + r32) * 64 + 16 * s + 8 * hi);
            gr = MFMA32(ac, bfr[s], gr); gs = MFMA32(as, bfr[s], gs);
        }
#pragma unroll
        for (int r = 0; r < 16; ++r) {
            const int k1 = 32 * mt + crow(r, hi);
            const float c = twc[k1], sn = tws[k1], Gr = gr[r], Gi = -gs[r];
            const float pr = (Gr * c + Gi * sn) * 0.125f, pi = (Gi * c - Gr * sn) * 0.125f;
            bf16_t* gp = GP + ((size_t)((b * 64 + k1) * 128 + s2) * 2) * 256 + wid * 32 + r32;
            gp[0] = bf1(pr); gp[256] = bf1(pi);
        }
    }
    __syncthreads();
}
__device__ __forceinline__ void fc_unit(LAS unsigned char* lds, const bf16_t* GP, bf16_t* ycat, const unsigned char* tb, int b, int k1, int chalf) {
    const int tid = fresh_tid(), lane = tid & 63, r32 = lane & 31, hi = lane >> 5, wid = __builtin_amdgcn_readfirstlane(tid >> 6);
    const bf16_t* gsrc = GP + (size_t)(b * 64 + k1) * 128 * 2 * 256 + chalf * 128;
#pragma unroll
    for (int i = 0; i < 8; ++i) {
        const int idx = tid + 512 * i, row = idx >> 4, ch = idx & 15, s2 = row >> 1, ri = row & 1;
        const u32x4 v = *(const u32x4*)(gsrc + (size_t)row * 256 + ch * 8);
        *(LAS u32x4*)(lds + ((ch >> 2) * 2 + ri) * 8192 + s2 * 64 + (ch & 3) * 16) = v;
    }
    __syncthreads();
    const int cblk = wid & 3, kh = wid >> 2;
    const int i16 = lane & 15, q = i16 >> 2, p = i16 & 3, blk = (lane >> 4) & 1;
    const LAS unsigned char* bpr = lds + (cblk * 2) * 8192 + (8 * hi + q) * 64 + blk * 32 + p * 8;
    const LAS unsigned char* bpi = bpr + 8192;
    const bf16_t* T128c = (const bf16_t*)(tb + TB_128C); const bf16_t* T128s = (const bf16_t*)(tb + TB_128S);
    f32x16 xr[2], sf[2];
#pragma unroll
    for (int mt = 0; mt < 2; ++mt)
#pragma unroll
        for (int r = 0; r < 16; ++r) { xr[mt][r] = 0.f; sf[mt][r] = 0.f; }
#pragma unroll
    for (int s = 0; s < 8; ++s) {
        const bf16x8 br = cat8(vtr(bpr + s * 1024), vtr(bpr + s * 1024 + 256));
        const bf16x8 bi = cat8(vtr(bpi + s * 1024), vtr(bpi + s * 1024 + 256));
#pragma unroll
        for (int mt = 0; mt < 2; ++mt) {
            const int krow = 32 * (2 * kh + mt) + r32;
            const bf16x8 ac = *(const bf16x8*)(T128c + krow * 128 + 16 * s + 8 * hi);
            const bf16x8 as = *(const bf16x8*)(T128s + krow * 128 + 16 * s + 8 * hi);
            const bf16x8 nc = ac ^ (short)0x8000;
            xr[mt] = MFMA32(ac, br, xr[mt]); xr[mt] = MFMA32(as, bi, xr[mt]);
            sf[mt] = MFMA32(as, br, sf[mt]); sf[mt] = MFMA32(nc, bi, sf[mt]);
        }
    }
    const float sc = 0.08838834764831845f;
#pragma unroll
    for (int mt = 0; mt < 2; ++mt)
#pragma unroll
        for (int r = 0; r < 16; ++r) {
            const int k2 = 32 * (2 * kh + mt) + crow(r, hi), k = k1 + 64 * k2;
            bf16_t* yp = ycat + (size_t)(b * SEQ + k) * YW + 256 + chalf * 128 + cblk * 32 + r32;
            yp[0] = bf1(xr[mt][r] * sc); yp[256] = bf1(sf[mt][r] * sc);
        }
    __syncthreads();
}

constexpr int AT_KB = 17408, AT_VS = 4096, AT_VB = 4 * AT_VS, AT_VOFF = 2 * AT_KB, AT_MISC = AT_VOFF + 3 * AT_VB;
__device__ __forceinline__ float wave_max(float v) {
#pragma unroll
    for (int o = 1; o < 64; o <<= 1) v = fmaxf(v, __shfl_xor(v, o));
    return v;
}
__device__ __forceinline__ float wave_min(float v) {
#pragma unroll
    for (int o = 1; o < 64; o <<= 1) v = fminf(v, __shfl_xor(v, o));
    return v;
}
#pragma float_control(push)
#pragma float_control(precise, off)
__device__ __forceinline__ float rowmax32(const f32x16& a, const f32x16& b) {
    float m0 = __builtin_fmaxf(a[0], b[0]), m1 = __builtin_fmaxf(a[1], b[1]);
#pragma unroll
    for (int r = 2; r < 16; r += 2) { m0 = __builtin_fmaxf(m0, __builtin_fmaxf(a[r], b[r])); m1 = __builtin_fmaxf(m1, __builtin_fmaxf(a[r + 1], b[r + 1])); }
    return __builtin_fmaxf(m0, m1);
}
#pragma float_control(pop)
__device__ __forceinline__ float bflo(unsigned u) { return __uint_as_float(u << 16); }
__device__ __forceinline__ float bfhi(unsigned u) { return __uint_as_float(u & 0xffff0000u); }
__device__ __forceinline__ void knorm_items(const bf16_t* KC, float* knmax) {
    const int tid = fresh_tid(), lane = tid & 63, wave = tid >> 6;
    for (int item = blockIdx.x * 8 + wave; item < 2048; item += gridDim.x * 8) {
        const int tile = item & 127, j = (item >> 7) & 1, h = (item >> 8) & 3, b = item >> 10;
        const bf16_t* kp = KC + ((size_t)((b * 4 + h) * SEQ + tile * 64 + lane)) * 128 + j * 64;
        float s = 0.f;
#pragma unroll
        for (int i = 0; i < 8; ++i) {
            const u32x4 v = *(const u32x4*)(kp + 8 * i);
            s += (bflo(v.x) * bflo(v.x) + bfhi(v.x) * bfhi(v.x)) + (bflo(v.y) * bflo(v.y) + bfhi(v.y) * bfhi(v.y)) + (bflo(v.z) * bflo(v.z) + bfhi(v.z) * bfhi(v.z)) + (bflo(v.w) * bflo(v.w) + bfhi(v.w) * bfhi(v.w));
        }
        const float n = wave_max(sqrtf(s));
        if (lane == 0) knmax[item] = n;
    }
}
__device__ __forceinline__ void attn_unit(LAS unsigned char* lds, const bf16_t* QC, bf16_t* ycat, const float* knmax, int b, int h, int qb, float lam, float outscale, const float* hn) {
    const int tid = fresh_tid(), lane = tid & 63, r32 = lane & 31, hi = lane >> 5, wid = __builtin_amdgcn_readfirstlane(tid >> 6);
    const int j = wid & 1, qs = wid >> 1, q0 = qb * 128 + qs * 32;
    const size_t rowbase = (size_t)b * SEQ;
    LAS float* knl = (LAS float*)(lds + AT_MISC); LAS float* red = knl + 256;
    bf16x8 qf[4];
    {
        const bf16_t* Qp = QC + ((size_t)((b * 4 + h) * SEQ + q0 + r32)) * 128 + j * 64 + 8 * hi;
#pragma unroll
        for (int s = 0; s < 4; ++s) qf[s] = *(const bf16x8*)(Qp + 16 * s);
        float q2 = 0.f;
#pragma unroll
        for (int s = 0; s < 4; ++s) { const u32x4 w = __builtin_bit_cast(u32x4, qf[s]);
            q2 += (bflo(w.x) * bflo(w.x) + bfhi(w.x) * bfhi(w.x)) + (bflo(w.y) * bflo(w.y) + bfhi(w.y) * bfhi(w.y)) + (bflo(w.z) * bflo(w.z) + bfhi(w.z) * bfhi(w.z)) + (bflo(w.w) * bflo(w.w) + bfhi(w.w) * bfhi(w.w)); }
        q2 += __shfl_xor(q2, 32);
        const float qn = wave_max(sqrtf(q2));
        if (lane == 0) red[wid] = qn;
        if (tid < 256) knl[tid] = knmax[(b * 4 + h) * 256 + tid];
    }
    const int key0 = tid >> 4, ch = tid & 15;
    const bf16_t* Ksrc = QC + (8u << 20) + ((size_t)((b * 4 + h) * SEQ)) * 128 + tid * 8;
    const int kdst = key0 * 272 + ch * 16, vdst = AT_VOFF + (ch >> 2) * AT_VS + key0 * 64 + (ch & 3) * 16;
    u32x4 ska0, ska1, sva0, sva1;
#define AT_LOAD(S, t) do { const bf16_t* kp_ = Ksrc + (size_t)(t) * 8192; sk##S##0 = *(const u32x4*)kp_; sk##S##1 = *(const u32x4*)(kp_ + 4096); sv##S##0 = *(const u32x4*)(kp_ + (8u << 20)); sv##S##1 = *(const u32x4*)(kp_ + (8u << 20) + 4096); } while (0)
#define AT_STORE(S, kb_, vb_) do { *(LAS u32x4*)(lds + (kb_) * AT_KB + kdst) = sk##S##0; *(LAS u32x4*)(lds + (kb_) * AT_KB + kdst + 32 * 272) = sk##S##1; \
        *(LAS u32x4*)(lds + (vb_) * AT_VB + vdst) = sv##S##0; *(LAS u32x4*)(lds + (vb_) * AT_VB + vdst + 32 * 64) = sv##S##1; } while (0)
    f32x16 o[4];
#pragma unroll
    for (int et = 0; et < 4; ++et)
#pragma unroll
        for (int r = 0; r < 16; ++r) o[et][r] = 0.f;
    float m = -64.0f, l = 0.f;
    const float cb = exp2f(-2.0f * (float)(h + 1)) * LOG2E;
    const float qpos = (float)(q0 + r32);
    const int i16 = lane & 15, tq = i16 >> 2, tp = i16 & 3, blk = (lane >> 4) & 1;
    const int koff = r32 * 272 + (64 * j + 8 * hi) * 2;
    const int voff = AT_VOFF + (4 * hi + tq) * 64 + blk * 32 + tp * 8;
    const int td0 = 2 * qb;
    u32x4 ab0 = {0u, 0u, 0u, 0u}, ab1 = {0u, 0u, 0u, 0u};
    if (hi == 0) {
        const float c0 = cb * (float)r32, c1 = cb * (float)(r32 + 32);
        const unsigned h0 = pk2(c0, 0.f) & 0xffffu, h1 = pk2(c1, 0.f) & 0xffffu;
        ab0.x = h0 | (pk2(c0 - __uint_as_float(h0 << 16), 0.f) << 16);
        ab1.x = h1 | (pk2(c1 - __uint_as_float(h1 << 16), 0.f) << 16);
    }
    const bool grpB = wid >= 4;
    bf16x8 pa[4];
#pragma unroll
    for (int ks = 0; ks < 4; ++ks) pa[ks] = (bf16x8){0, 0, 0, 0, 0, 0, 0, 0};
#define AT_SEQ(i) ((i) < 2 ? td0 + (i) : (((i) - 2 < td0) ? td0 - 1 - ((i) - 2) : (i)))
#define SB() __builtin_amdgcn_sched_barrier(0)
#define AT_VRD(dst, ks) do { _Pragma("unroll") for (int et = 0; et < 4; ++et) dst[et] = cat8(vtr(vp_ + et * AT_VS + (ks) * 1024), vtr(vp_ + et * AT_VS + (ks) * 1024 + 512)); } while (0)
#define AT_VMM(src, ks) do { _Pragma("unroll") for (int et = 0; et < 4; ++et) o[et] = MFMA32(src[et], pa[ks], o[et]); } while (0)
#define AT_PV(vbuf) do { const LAS unsigned char* vp_ = lds + (vbuf) * AT_VB + voff; \
        _Pragma("unroll") for (int ks = 0; ks < 4; ++ks) _Pragma("unroll") for (int et = 0; et < 4; ++et) { \
            const bf16x8 vf_ = cat8(vtr(vp_ + et * AT_VS + ks * 1024), vtr(vp_ + et * AT_VS + ks * 1024 + 512)); o[et] = MFMA32(vf_, pa[ks], o[et]); } } while (0)
    int T = td0;
    AT_LOAD(a, T); AT_STORE(a, 0, 0);
    __syncthreads();
    const float qmax0 = fmaxf(fmaxf(red[0], red[2]), fmaxf(red[4], red[6])), qmax1 = fmaxf(fmaxf(red[1], red[3]), fmaxf(red[5], red[7]));
    float thr0 = -3e38f, thr1 = -3e38f;
    int kbuf = 0, vbuf = 0, vprev = 0, i = 0;
#pragma unroll 1
    for (;;) {
        int in = i + 1, Tn = -1;
        while (in < SEQ / 64) {
            const int Tc = AT_SEQ(in);
            if (in < 3) { Tn = Tc; break; }
            const float dmin = (Tc < td0) ? (float)(128 * qb - 64 * Tc - 63) : (float)(64 * Tc - 128 * qb - 127);
            if (qmax0 * knl[Tc] - cb * dmin + 1.0f >= thr0 || qmax1 * knl[128 + Tc] - cb * dmin + 1.0f >= thr1) { Tn = Tc; break; }
            ++in;
        }
        if (Tn >= 0) AT_LOAD(a, Tn);
        if (grpB && i > 0) AT_PV(vprev);
        f32x16 S0, S1;
        const bool offd = (i >= 2);
        float tadd = 0.f;
        u32x4 bb = {0u, 0u, 0u, 0u};
        if (offd) { const bool left = T < td0; bb.x = (hi == 0) ? (left ? 0x3F803F80u : 0xBF80BF80u) : 0u; const float tt = cb * ((float)(64 * T) - qpos); tadd = left ? tt : -tt; }
        {
            const float c0 = tadd - m;
#pragma unroll
            for (int r = 0; r < 16; ++r) { S0[r] = c0; S1[r] = c0; }
            const LAS unsigned char* kp = lds + kbuf * AT_KB + koff;
#pragma unroll
            for (int s = 0; s < 4; ++s) {
                const bf16x8 k0 = *(const LAS bf16x8*)(kp + s * 32), k1 = *(const LAS bf16x8*)(kp + 32 * 272 + s * 32);
                S0 = MFMA32(k0, qf[s], S0); S1 = MFMA32(k1, qf[s], S1);
            }
            S0 = MFMA32(__builtin_bit_cast(bf16x8, ab0), __builtin_bit_cast(bf16x8, bb), S0); S1 = MFMA32(__builtin_bit_cast(bf16x8, ab1), __builtin_bit_cast(bf16x8, bb), S1);
        }
        if (!offd) {
            const float kb = (float)(T * 64 + 4 * hi) - qpos;
#pragma unroll
            for (int r = 0; r < 16; ++r) {
                const float d0 = kb + (float)((r & 3) + 8 * (r >> 2));
                S0[r] = fmaf(-cb, fabsf(d0), S0[r]); S1[r] = fmaf(-cb, fabsf(d0 + 32.0f), S1[r]);
            }
        }
        {
            float mt = rowmax32(S0, S1);
            { const auto sw_ = __builtin_amdgcn_permlane32_swap(__float_as_uint(mt), __float_as_uint(mt), false, false); mt = fmaxf(__uint_as_float(sw_[0]), __uint_as_float(sw_[1])); }
            if (__any(mt > 0.f)) {
                const float dl = fmaxf(mt, 0.f), f = __builtin_amdgcn_exp2f(-dl);
                l *= f; m += dl;
#pragma unroll
                for (int et = 0; et < 4; ++et) o[et] = o[et] * f;
                S0 = S0 - dl; S1 = S1 - dl;
            }
        }
        float lsa = 0.f, lsb = 0.f;
#pragma unroll
        for (int r = 0; r < 16; r += 2) {
            S0[r] = __builtin_amdgcn_exp2f(S0[r]); S0[r + 1] = __builtin_amdgcn_exp2f(S0[r + 1]); S1[r] = __builtin_amdgcn_exp2f(S1[r]); S1[r + 1] = __builtin_amdgcn_exp2f(S1[r + 1]);
            lsa += S0[r]; asm volatile("" : "+v"(lsa)); lsb += S0[r + 1]; asm volatile("" : "+v"(lsb)); lsa += S1[r]; asm volatile("" : "+v"(lsa)); lsb += S1[r + 1]; asm volatile("" : "+v"(lsb));
        }
        l += lsa + lsb;
        { u32x4 w;
          w.x = pk2(S0[0], S0[1]); w.y = pk2(S0[2], S0[3]); w.z = pk2(S0[4], S0[5]); w.w = pk2(S0[6], S0[7]); pa[0] = __builtin_bit_cast(bf16x8, w);
          w.x = pk2(S0[8], S0[9]); w.y = pk2(S0[10], S0[11]); w.z = pk2(S0[12], S0[13]); w.w = pk2(S0[14], S0[15]); pa[1] = __builtin_bit_cast(bf16x8, w);
          w.x = pk2(S1[0], S1[1]); w.y = pk2(S1[2], S1[3]); w.z = pk2(S1[4], S1[5]); w.w = pk2(S1[6], S1[7]); pa[2] = __builtin_bit_cast(bf16x8, w);
          w.x = pk2(S1[8], S1[9]); w.y = pk2(S1[10], S1[11]); w.z = pk2(S1[12], S1[13]); w.w = pk2(S1[14], S1[15]); pa[3] = __builtin_bit_cast(bf16x8, w); }
        if (!grpB) AT_PV(vbuf);
        if (i == 1) { const float wm = wave_min(m > -64.0f ? m : -3e38f); if (lane == 0) red[8 + wid] = wm; }
        const int vnext = (vbuf == 2) ? 0 : vbuf + 1;
        if (Tn >= 0) AT_STORE(a, kbuf ^ 1, vnext);
        __syncthreads();
        if (i == 1) { thr0 = fminf(fminf(red[8], red[10]), fminf(red[12], red[14])) - 41.0f; thr1 = fminf(fminf(red[9], red[11]), fminf(red[13], red[15])) - 41.0f; }
        vprev = vbuf;
        if (Tn < 0) break;
        i = in; T = Tn; kbuf ^= 1; vbuf = vnext;
    }
    if (grpB) AT_PV(vprev);
    __syncthreads();
#undef AT_PV
#undef AT_VRD
#undef AT_VMM
#undef SB
#undef AT_LOAD
#undef AT_STORE
#undef AT_SEQ
    l += __shfl_xor(l, 32);
    float inv = 1.0f / l; if (j == 1) inv *= lam;
    LAS float* xb = (LAS float*)lds + qs * 4096;
    if (j == 1) {
#pragma unroll
        for (int et = 0; et < 4; ++et)
#pragma unroll
            for (int r = 0; r < 16; ++r) xb[(32 * et + crow(r, hi)) * 32 + r32] = o[et][r] * inv;
    }
    __syncthreads();
    if (j == 0) {
        float sq = 0.f;
#pragma unroll
        for (int et = 0; et < 4; ++et)
#pragma unroll
            for (int r = 0; r < 16; ++r) { const float d = o[et][r] * inv - xb[(32 * et + crow(r, hi)) * 32 + r32]; o[et][r] = d; sq += d * d; }
        sq += __shfl_xor(sq, 32);
        const float rn = rsqrtf(sq * (1.0f / 128.0f) + EPS) * outscale;
        bf16_t* yo = ycat + (rowbase + q0 + r32) * YW + 768 + h * 128;
#pragma unroll
        for (int et = 0; et < 4; ++et)
#pragma unroll
            for (int g = 0; g < 4; ++g) {
                const int e0 = 32 * et + 8 * g + 4 * hi;
                const f32x4 hv = *(const f32x4*)(hn + h * 128 + e0);
                u32x2 w; w.x = pk2(o[et][4 * g] * rn * hv.x, o[et][4 * g + 1] * rn * hv.y); w.y = pk2(o[et][4 * g + 2] * rn * hv.z, o[et][4 * g + 3] * rn * hv.w);
                *(u32x2*)(yo + e0) = w;
            }
    }
    __syncthreads();
}

__device__ __forceinline__ void phase_final(CArgs* a) {
    const int tid = fresh_tid(), lane = tid & 63, wave = tid >> 6;
    const bf16_t* xl = (const bf16_t*)(a->ws + WS_XF); const bf16_t* xh = (const bf16_t*)(a->ws + WS_XB);
    const float* ss = (const float*)(a->ws + WS_SS) + (size_t)12 * MTOK * 16; const float* gn = a->in[20];
    f32x4 g[4];
#pragma unroll
    for (int j = 0; j < 4; ++j) g[j] = ((const f32x4*)gn)[lane + 64 * j];
    for (int row0 = blockIdx.x * 8 + wave; row0 < MTOK; row0 += gridDim.x * 16) {
        const int row1 = row0 + gridDim.x * 8; const bool has1 = row1 < MTOK; const int r1 = has1 ? row1 : row0;
        const u32x2* hr0 = (const u32x2*)(xh + (size_t)row0 * DM) + lane; const u32x2* lr0 = (const u32x2*)(xl + (size_t)row0 * DM) + lane;
        const u32x2* hr1 = (const u32x2*)(xh + (size_t)r1 * DM) + lane; const u32x2* lr1 = (const u32x2*)(xl + (size_t)r1 * DM) + lane;
        u32x2 h0[4], l0[4], h1[4], l1[4];
#pragma unroll
        for (int j = 0; j < 4; ++j) { h0[j] = hr0[64 * j]; l0[j] = lr0[64 * j]; h1[j] = hr1[64 * j]; l1[j] = lr1[64 * j]; }
        const float ra = row_rs(ss, row0), rb = row_rs(ss, r1);
        f32x4* oo0 = (f32x4*)(a->out + (size_t)row0 * DM) + lane; f32x4* oo1 = (f32x4*)(a->out + (size_t)r1 * DM) + lane;
#pragma unroll
        for (int j = 0; j < 4; ++j) {
            const f32x4 x = {__uint_as_float(h0[j].x << 16) + __uint_as_float(l0[j].x << 16), __uint_as_float(h0[j].x & 0xffff0000u) + __uint_as_float(l0[j].x & 0xffff0000u),
                             __uint_as_float(h0[j].y << 16) + __uint_as_float(l0[j].y << 16), __uint_as_float(h0[j].y & 0xffff0000u) + __uint_as_float(l0[j].y & 0xffff0000u)};
            oo0[64 * j] = x * ra * g[j];
        }
        if (has1) {
#pragma unroll
            for (int j = 0; j < 4; ++j) {
                const f32x4 x = {__uint_as_float(h1[j].x << 16) + __uint_as_float(l1[j].x << 16), __uint_as_float(h1[j].x & 0xffff0000u) + __uint_as_float(l1[j].x & 0xffff0000u),
                                 __uint_as_float(h1[j].y << 16) + __uint_as_float(l1[j].y << 16), __uint_as_float(h1[j].y & 0xffff0000u) + __uint_as_float(l1[j].y & 0xffff0000u)};
                oo1[64 * j] = x * rb * g[j];
            }
        }
    }
}

__device__ __forceinline__ void grid_bar(unsigned* ctr, unsigned target) {
    __syncthreads();
    if (fresh_tid() == 0) {
        __builtin_amdgcn_fence(__ATOMIC_RELEASE, "agent");
        __hip_atomic_fetch_add(ctr, 1u, __ATOMIC_RELAXED, __HIP_MEMORY_SCOPE_AGENT);
        while (__hip_atomic_load(ctr, __ATOMIC_RELAXED, __HIP_MEMORY_SCOPE_AGENT) < target) __builtin_amdgcn_s_sleep(2);
        __builtin_amdgcn_fence(__ATOMIC_ACQUIRE, "agent");
    }
    __syncthreads();
}
__device__ __forceinline__ void grid_bar2(unsigned* xarr, unsigned* top, unsigned nb, unsigned per) {
    asm volatile("s_waitcnt vmcnt(0)" ::: "memory");
    __syncthreads();
    if (fresh_tid() == 0) {
        const unsigned old = __hip_atomic_fetch_add(xarr, 1u, __ATOMIC_RELAXED, __HIP_MEMORY_SCOPE_AGENT);
        if (old + 1u == nb * per) { __builtin_amdgcn_fence(__ATOMIC_RELEASE, "agent"); __hip_atomic_fetch_add(top, 1u, __ATOMIC_RELAXED, __HIP_MEMORY_SCOPE_AGENT); }
        while (__hip_atomic_load(top, __ATOMIC_RELAXED, __HIP_MEMORY_SCOPE_AGENT) < nb * 8u) __builtin_amdgcn_s_sleep(2);
        __builtin_amdgcn_fence(__ATOMIC_ACQUIRE, "agent");
    }
    __syncthreads();
}
__device__ __forceinline__ unsigned xcc_id() { return (unsigned)__builtin_amdgcn_s_getreg((3 << 11) | 20) & 0xFu; }
__device__ __forceinline__ void xcd_bar(unsigned* ctr, unsigned target) {
    asm volatile("s_waitcnt vmcnt(0)" ::: "memory");
    __syncthreads();
    if (fresh_tid() == 0) {
        __hip_atomic_fetch_add(ctr, 1u, __ATOMIC_RELAXED, __HIP_MEMORY_SCOPE_AGENT);
        while (__hip_atomic_load(ctr, __ATOMIC_RELAXED, __HIP_MEMORY_SCOPE_AGENT) < target) __builtin_amdgcn_s_sleep(1);
        __builtin_amdgcn_fence(__ATOMIC_ACQUIRE, "agent");
    }
    __syncthreads();
}
__global__ void __launch_bounds__(512, 2) mega_fwd(Args a_val) {
    extern __shared__ __attribute__((aligned(16))) unsigned char lds_raw[];
    LAS unsigned char* lds = (LAS unsigned char*)lds_raw;
    const int ph_lo = a_val.ph_lo, ph_hi = a_val.ph_hi, coop = a_val.coop;
    unsigned nbar = 0, nxbar = 0, nbar2 = 0;
    LAS unsigned* blk = (LAS unsigned*)(lds + LDS_BYTES - 32);
    if (coop && ph_lo == 0) {
        if (fresh_tid() == 0) { const unsigned x = xcc_id() & 7u; blk[2] = x; blk[0] = __hip_atomic_fetch_add((unsigned*)(a_val.ws + WS_MISC + 640) + x, 1u, __ATOMIC_RELAXED, __HIP_MEMORY_SCOPE_AGENT) * 8u + x; blk[1] = 0u; }
    } else if (fresh_tid() == 0) { blk[0] = blockIdx.x; blk[1] = 0u; blk[2] = 0u; }
    __syncthreads();
    for (int ph = ph_lo; ph < ph_hi; ++ph) {
        CArgs* a = (CArgs*)__builtin_amdgcn_kernarg_segment_ptr();
        asm volatile("" : "+s"(a));
        unsigned char* ws = a->ws;
        float* xf = (float*)(ws + WS_XF); bf16_t* xb = (bf16_t*)(ws + WS_XB); float* ssb = (float*)(ws + WS_SS);
        bf16_t* act = (bf16_t*)(ws + WS_ACT); bf16_t* P = (bf16_t*)(ws + WS_P); bf16_t* ycat = (bf16_t*)(ws + WS_YCAT); bf16_t* GP = (bf16_t*)(ws + WS_GP);
        const unsigned char* tb = ws + WS_TAB;
        if (ph == 0) phase_p0(a, lds);
        else if (ph == NPHASE - 1) phase_final(a);
        else {
            const int l = (ph - 1) >> 3, k = (ph - 1) & 7;
            unsigned char* wb = wbuf(ws, l);
            for (int rep = 0; rep < (((PROBE_MASK >> k) & 1) ? 2 : 1); ++rep) {
            if (k == 0 || k == 6) {
                pg8::Gemm g{xb, (const bf16_t*)(wb + (k == 0 ? W_GU1 : W_GU2)), MTOK, 2 * DFF, DM}; pg8::StaticOrder S; S.init(MTOK, 2 * DFF, gridDim.x, (int)blk[0]);
                EpiSwiGLU E{act, ssb + (size_t)(3 * l + (k == 0 ? 0 : 2)) * MTOK * 16};
                pg8::gemm_phase<EpiSwiGLU, pg8::StaticOrder, true, true>(lds, g, S, E);
            } else if (k == 1 || k == 7 || k == 5) {
                const bf16_t* A = (k == 5) ? ycat : act; const int K = (k == 5) ? YW : DFF;
                const bf16_t* Bt = (const bf16_t*)(wb + (k == 1 ? W_D1 : (k == 7 ? W_D2 : W_O)));
                pg8::Gemm g{A, Bt, MTOK, DM, K}; pg8::StaticOrder S; S.init(MTOK, DM, gridDim.x, (int)blk[0]);
                EpiResid E{(l == 0 && k == 1) ? a->in[0] : (const float*)nullptr, (bf16_t*)xf, xb, ssb + (size_t)(3 * l + (k == 1 ? 1 : (k == 5 ? 2 : 3))) * MTOK * 16, (k == 5) ? 1.0f : 0.5f};
                pg8::gemm_phase<EpiResid, pg8::StaticOrder, true, true>(lds, g, S, E);
            } else if (k == 2) {
                pg8::Gemm g{xb, (const bf16_t*)(wb + W_IN), MTOK, 2048, DM}; pg8::StaticOrder S; S.init(MTOK, 2048, gridDim.x, (int)blk[0]);
                EpiWin E{P, (bf16_t*)(ws + WS_QC), ssb + (size_t)(3 * l + 1) * MTOK * 16};
                pg8::gemm_phase<EpiWin, pg8::StaticOrder, true, true>(lds, g, S, E);
            } else if (k == 3) {
                for (int u = blockIdx.x; u < 256; u += gridDim.x) fa_unit(lds, P, GP, tb, u >> 7, u & 127);
                for (int u = blockIdx.x; u < 256; u += gridDim.x) pool_unit(P, ycat, u);
                knorm_items((const bf16_t*)(ws + WS_KC), (float*)(ws + WS_MISC + 1024));
                fold_wout(a, l);
            } else {
                const float lam = ((const float*)(ws + WS_MISC))[l];
                const float outscale = 1.0f - (0.8f - 0.6f * expf(-0.3f * (float)l));
                unsigned* ctr = (unsigned*)(ws + WS_MISC + 256) + l;
                LAS int* uslot = (LAS int*)(lds + AT_MISC + 1024 + 64);
                const int nwork = 768 + ((l + 1 < NLAYER) ? CONV_CHUNKS : 0);
                for (;;) {
                    if (fresh_tid() == 0) *uslot = (int)atomicAdd(ctr, 1u);
                    __syncthreads();
                    const int u = *uslot;
                    __syncthreads();
                    if (u >= nwork) break;
                    if (u >= 512 && u < 768) { const int v = u - 512; fc_unit(lds, GP, ycat, tb, v >> 7, (v >> 1) & 63, v & 1); }
                    else if (u < 512) attn_unit(lds, (const bf16_t*)(ws + WS_QC), ycat, (const float*)(ws + WS_MISC + 1024), (u >> 6) & 1, 3 - (u >> 7), u & 63, lam, outscale, a->in[14] + l * 512);
                    else conv_chunk(a, l + 1, u - 768, lds);
                }
            }
            }
        }
        if (coop && ph + 1 < ph_hi) {
            if (coop == 2) cg::this_grid().sync();
            else {
                const int kk = (ph - 1) & 7;
                const bool local = blk[1] != 0u && ph >= 1 && ph < NPHASE - 2 && (kk == 0 || kk == 1 || kk >= 5);
                if (local) { ++nxbar; xcd_bar((unsigned*)(ws + WS_MISC + 704) + blk[2], nxbar * (gridDim.x >> 3)); }
                else if (blk[1] != 0u) { ++nbar2; grid_bar2((unsigned*)(ws + WS_MISC + 576) + blk[2], (unsigned*)(ws + WS_MISC + 516), nbar2, gridDim.x >> 3); }
                else { ++nbar; grid_bar((unsigned*)(ws + WS_MISC + 512), nbar * gridDim.x); }
                if (ph == 0) {
                    if (fresh_tid() == 0) {
                        bool even = (gridDim.x & 7u) == 0u;
                        for (int x = 0; x < 8; ++x) even = even && (__hip_atomic_load((unsigned*)(ws + WS_MISC + 640) + x, __ATOMIC_RELAXED, __HIP_MEMORY_SCOPE_AGENT) == (gridDim.x >> 3));
                        if (even) blk[1] = 1u; else blk[0] = blockIdx.x;
                    }
                    __syncthreads();
                }
            }
        }
    }
}

extern "C" void kernel_launch(void* const* d_in, const int* in_sizes, int n_in, void* d_out, int out_size, void* d_ws, size_t ws_size, hipStream_t stream) {
    static int grid = 0;
    if (grid == 0) {
        if (n_in != 21 || in_sizes[0] != MTOK * DM || out_size != MTOK * DM || ws_size < WS_END) {
            fprintf(stderr, "kernel_launch: unexpected problem (n_in %d, in0 %d, out %d, ws %zu); nothing launched\n", n_in, n_in > 0 ? in_sizes[0] : -1, out_size, ws_size); grid = -1; return; }
        int dev = 0, cus = 0, per_cu = 0;
        if (hipGetDevice(&dev) != hipSuccess || hipDeviceGetAttribute(&cus, hipDeviceAttributeMultiprocessorCount, dev) != hipSuccess) { fprintf(stderr, "kernel_launch: device query failed\n"); grid = -1; return; }
        if (hipFuncSetAttribute((const void*)mega_fwd, hipFuncAttributeMaxDynamicSharedMemorySize, LDS_BYTES) != hipSuccess) { fprintf(stderr, "kernel_launch: hipFuncSetAttribute failed\n"); grid = -1; return; }
        if (hipOccupancyMaxActiveBlocksPerMultiprocessor(&per_cu, (const void*)mega_fwd, 512, LDS_BYTES) != hipSuccess || per_cu < 1) { fprintf(stderr, "kernel_launch: occupancy query says %d blocks per CU\n", per_cu); per_cu = 1; }
        (void)hipGetLastError();
        grid = cus * per_cu;
    }
    if (grid < 0) return;
    Args a{};
    for (int i = 0; i < 21; ++i) a.in[i] = (const float*)d_in[i];
    a.out = (float*)d_out; a.ws = (unsigned char*)d_ws;
#if MK_MULTI
    for (int ph = 0; ph < NPHASE; ++ph) {
        a.ph_lo = ph; a.ph_hi = ph + 1; a.coop = 0;
        hipLaunchKernelGGL(mega_fwd, dim3(grid), dim3(512), LDS_BYTES, stream, a);
    }
#else
    a.ph_lo = 0; a.ph_hi = NPHASE; a.coop = 1;
    if (hipMemsetAsync((unsigned char*)d_ws + WS_MISC + 512, 0, 256, stream) != hipSuccess) { fprintf(stderr, "kernel_launch: hipMemsetAsync failed\n"); return; }
    void* args[] = {&a};
    hipError_t e = hipLaunchCooperativeKernel((const void*)mega_fwd, dim3(grid), dim3(512), args, LDS_BYTES, stream);
    if (e != hipSuccess) fprintf(stderr, "kernel_launch: cooperative launch failed: %s (grid %d)\n", hipGetErrorString(e), grid);
#endif
}
```

```cpp
#include <hip/hip_runtime.h>
#include <hip/hip_cooperative_groups.h>
#include <cstdio>
#include <cstdint>
namespace cg = cooperative_groups;
__device__ __forceinline__ int fresh_tid();
namespace pg8 {
#define PG8_LAS __attribute__((address_space(3)))
typedef unsigned short bf16_t;
typedef short bf16x8 __attribute__((ext_vector_type(8)));
typedef float f32x4 __attribute__((ext_vector_type(4)));
typedef unsigned u32x4 __attribute__((ext_vector_type(4)));
constexpr int BM = 256, BK = 64, HALF = 128, HTB = HALF * BK * 2  , STAGE_BYTES = 8 * HTB, NXCD = 8, WGM = 8;

__host__ __device__ __forceinline__ int lds_byte(int r, int c) { const int st = (r >> 4) * 2 + (c >> 5), rr = r & 15, cc = c & 31, ob = rr * 64 + cc * 2; return st * 1024 + (ob ^ (((ob >> 9) & 1) << 5)); }
__host__ __device__ __forceinline__ void stage_rc(int b, int& R, int& C) { const int st = b / 1024, sb = b % 1024, swz = sb ^ (((sb >> 9) & 1) << 5); R = (st >> 1) * 16 + swz / 64; C = (st & 1) * 32 + (swz % 64) / 2; }
__host__ __device__ __forceinline__ int perm32(int rho) { const int n = rho >> 4, i = rho & 15; return 8 * (i >> 2) + 4 * n + (i & 3); }

struct Unit { int pm, pn; };
struct Gemm { const bf16_t* A; const bf16_t* Bt; int M, N, K; };

struct StaticOrder {
    int nM, nN, nwg, G, c;
    __host__ __device__ void init(int M, int N, int G_, int c_) { nM = M / BM; nN = N / BM; nwg = nM * nN; G = G_; c = c_; }
    __host__ __device__ bool next(int i, Unit& u) const {
        const long L = (long)i * G + c; if (L >= nwg) return false;
        int wgid = (int)L; { const int q = nwg / NXCD, r = nwg % NXCD, xcd = wgid % NXCD, off = wgid / NXCD; wgid = (xcd < r ? xcd * (q + 1) : r * (q + 1) + (xcd - r) * q) + off; }
        const int nig = WGM * nN, gid = wgid / nig, fm = gid * WGM, gsz = (nM - fm) < WGM ? (nM - fm) : WGM;
        u.pm = fm + ((wgid % nig) % gsz); u.pn = (wgid % nig) / gsz; return true;
    }
    __device__ __forceinline__ void a_ready(const Unit&) const {}
    __device__ __forceinline__ void done(const Unit&) const {}
};
__device__ __forceinline__ unsigned cvt_pk_bf16(float lo, float hi) { unsigned r; asm volatile("v_cvt_pk_bf16_f32 %0, %1, %2" : "=v"(r) : "v"(lo), "v"(hi)); return r; }
template <class Epi, class Sched, bool ALIGN_EPI = false, bool SP2 = false>
__device__ __forceinline__ void gemm_phase(PG8_LAS unsigned char* lds, const Gemm g, const Sched& S, const Epi& E) {
    const int tid = fresh_tid(), wid = __builtin_amdgcn_readfirstlane(tid >> 6), lane = tid & 63, wr = wid >> 2, wc = wid & 3, fr = lane & 15, fq = lane >> 4;
    const int K = g.K, nt = K / BK;
    unsigned voffA[2], voffB[2];
#pragma unroll
    for (int i = 0; i < 2; ++i) { int R, C; stage_rc(tid * 16 + i * 8192, R, C); const int Rb = Epi::PERM ? ((R & ~31) + perm32(R & 31)) : R;
        voffA[i] = (unsigned)(R * K + C) * 2u; voffB[i] = (unsigned)(Rb * K + C) * 2u; }
    const size_t kstep = (size_t)(BK * 2);
    const size_t hstep = (size_t)HALF * K * 2;
    const size_t tstep = 2 * hstep;
    const unsigned ldsw = (unsigned)wid * 1024u;
    const int aoff = lds_byte(wr * 64 + fr, fq * 8), boff = lds_byte(wc * 32 + fr, fq * 8);
#define PG8_SA(b, h) (((b) * 2 + (h)) * HTB)
#define PG8_SB(b, h) ((4 + (b) * 2 + (h)) * HTB)
#define PG8_STAGE(bufoff, gbase, voff) do { _Pragma("unroll") for (int _i = 0; _i < 2; ++_i) \
        __builtin_amdgcn_global_load_lds((const unsigned*)((const char*)(gbase) + (voff)[_i]), (PG8_LAS unsigned*)(lds + (bufoff) + ldsw + _i * 8192), 16, 0, 0); } while (0)
#define PG8_LDA(dst, b, h) do { _Pragma("unroll") for (int m = 0; m < 4; ++m) _Pragma("unroll") for (int k = 0; k < 2; ++k) dst[m][k] = *(const PG8_LAS bf16x8*)(lds + PG8_SA(b, h) + aoff + m * 2048 + k * 1024); } while (0)
#define PG8_LDB(dst, b, h) do { _Pragma("unroll") for (int n = 0; n < 2; ++n) _Pragma("unroll") for (int k = 0; k < 2; ++k) dst[n][k] = *(const PG8_LAS bf16x8*)(lds + PG8_SB(b, h) + boff + n * 2048 + k * 1024); } while (0)
#define PG8_MMA(ai, bj, At, Bt) do { __builtin_amdgcn_s_setprio(1); _Pragma("unroll") for (int m = 0; m < 4; ++m) _Pragma("unroll") for (int n = 0; n < 2; ++n) _Pragma("unroll") for (int k = 0; k < 2; ++k) \
        acc[ai][bj][m][n] = __builtin_amdgcn_mfma_f32_16x16x32_bf16(Bt[n][k], At[m][k], acc[ai][bj][m][n], 0, 0, 0); __builtin_amdgcn_s_setprio(0); } while (0)
#define PG8_WAIT_V(n) asm volatile("s_waitcnt vmcnt(" #n ")" ::: "memory")
#define PG8_WAIT_L(n) asm volatile("s_waitcnt lgkmcnt(" #n ")" ::: "memory")
#define PG8_BAR __builtin_amdgcn_s_barrier()
#define PG8_SCHED __builtin_amdgcn_sched_barrier(0)
    Unit cur, nxt; int ui = 0;
    if (!S.next(0, cur)) return;
    f32x4 acc[2][2][4][2];
#pragma unroll
    for (int a = 0; a < 2; ++a)
#pragma unroll
        for (int b = 0; b < 2; ++b)
#pragma unroll
            for (int m = 0; m < 4; ++m)
#pragma unroll
                for (int n = 0; n < 2; ++n) acc[a][b][m][n] = (f32x4){0.f, 0.f, 0.f, 0.f};
    bf16x8 At[4][2], B0[2][2], B1[2][2];
    const char* cA = (const char*)g.A + (size_t)cur.pm * tstep; const char* cB = (const char*)g.Bt + (size_t)cur.pn * tstep;
    S.a_ready(cur);
    if constexpr (SP2) {
        PG8_STAGE(PG8_SB(0, 0), cB, voffB); PG8_STAGE(PG8_SB(0, 1), cB + hstep, voffB); PG8_STAGE(PG8_SA(0, 0), cA, voffA); PG8_STAGE(PG8_SA(0, 1), cA + hstep, voffA);
        if (wr == 1) PG8_BAR;
        PG8_WAIT_V(2); PG8_BAR;
        PG8_STAGE(PG8_SB(1, 0), cB + kstep, voffB); PG8_STAGE(PG8_SA(1, 0), cA + kstep, voffA); PG8_STAGE(PG8_SB(1, 1), cB + hstep + kstep, voffB);
        PG8_WAIT_V(6); PG8_BAR;
    } else {
        PG8_STAGE(PG8_SB(0, 0), cB, voffB); PG8_STAGE(PG8_SA(0, 0), cA, voffA); PG8_STAGE(PG8_SB(0, 1), cB + hstep, voffB); PG8_STAGE(PG8_SA(0, 1), cA + hstep, voffA);
        if (wr == 1) PG8_BAR;
        PG8_WAIT_V(4); PG8_BAR;
        PG8_STAGE(PG8_SB(1, 0), cB + kstep, voffB); PG8_STAGE(PG8_SA(1, 0), cA + kstep, voffA); PG8_STAGE(PG8_SB(1, 1), cB + hstep + kstep, voffB);
        PG8_WAIT_V(6); PG8_BAR;
    }
    for (;;) {
        const bool has_next = S.next(ui + 1, nxt);
        const char* nA = has_next ? (const char*)g.A + (size_t)nxt.pm * tstep : cA; const char* nB = has_next ? (const char*)g.Bt + (size_t)nxt.pn * tstep : cB;
        for (int t = 0; t < nt; t += 2) {
            const bool last = (t == nt - 2);
            const char* a1 = cA + (size_t)(t + 1) * kstep;
            const char* a2 = last ? nA : cA + (size_t)(t + 2) * kstep; const char* b2 = last ? nB : cB + (size_t)(t + 2) * kstep;
            const char* a3 = a2 + kstep; const char* b3 = b2 + kstep;
            if (last && has_next) S.a_ready(nxt);
            if constexpr (SP2) {
            PG8_LDB(B0, 0, 0); PG8_LDB(B1, 0, 1); PG8_SCHED; PG8_LDA(At, 0, 0); PG8_STAGE(PG8_SA(1, 1), a1 + hstep, voffA);
            PG8_WAIT_V(8); PG8_WAIT_L(0); PG8_BAR; PG8_MMA(0, 0, At, B0); PG8_MMA(0, 1, At, B1); PG8_BAR; PG8_SCHED;
            PG8_LDA(At, 0, 1); PG8_STAGE(PG8_SB(0, 0), b2, voffB); PG8_STAGE(PG8_SB(0, 1), b2 + hstep, voffB); PG8_STAGE(PG8_SA(0, 0), a2, voffA);
            PG8_WAIT_V(8); PG8_WAIT_L(0); PG8_BAR; PG8_MMA(1, 0, At, B0); PG8_MMA(1, 1, At, B1); PG8_BAR; PG8_SCHED;
            PG8_LDB(B0, 1, 0); PG8_LDB(B1, 1, 1); PG8_SCHED; PG8_LDA(At, 1, 0); PG8_STAGE(PG8_SA(0, 1), a2 + hstep, voffA);
            PG8_WAIT_V(8); PG8_WAIT_L(0); PG8_BAR; PG8_MMA(0, 0, At, B0); PG8_MMA(0, 1, At, B1); PG8_BAR; PG8_SCHED;
            PG8_LDA(At, 1, 1); PG8_STAGE(PG8_SB(1, 0), b3, voffB); PG8_STAGE(PG8_SB(1, 1), b3 + hstep, voffB); PG8_STAGE(PG8_SA(1, 0), a3, voffA);
            PG8_WAIT_V(8); PG8_WAIT_L(0); PG8_BAR; PG8_MMA(1, 0, At, B0); PG8_MMA(1, 1, At, B1); PG8_BAR; PG8_SCHED;
            } else {
            PG8_LDB(B0, 0, 0); PG8_SCHED; PG8_LDA(At, 0, 0); PG8_STAGE(PG8_SA(1, 1), a1 + hstep, voffA);
            PG8_WAIT_L(8); PG8_BAR; PG8_WAIT_L(0); PG8_MMA(0, 0, At, B0); PG8_BAR; PG8_SCHED;
            PG8_LDB(B1, 0, 1); PG8_STAGE(PG8_SB(0, 0), b2, voffB);
            PG8_BAR; PG8_WAIT_L(0); PG8_MMA(0, 1, At, B1); PG8_BAR;
            PG8_LDA(At, 0, 1); PG8_STAGE(PG8_SA(0, 0), a2, voffA);
            PG8_BAR; PG8_WAIT_L(0); PG8_MMA(1, 0, At, B0); PG8_BAR; PG8_SCHED;
            PG8_STAGE(PG8_SB(0, 1), b2 + hstep, voffB);
            PG8_WAIT_V(6); PG8_BAR; PG8_MMA(1, 1, At, B1); PG8_BAR;
            PG8_LDB(B0, 1, 0); PG8_SCHED; PG8_LDA(At, 1, 0); PG8_STAGE(PG8_SA(0, 1), a2 + hstep, voffA);
            PG8_WAIT_L(8); PG8_BAR; PG8_WAIT_L(0); PG8_MMA(0, 0, At, B0); PG8_BAR; PG8_SCHED;
            PG8_LDB(B1, 1, 1); PG8_STAGE(PG8_SB(1, 0), b3, voffB);
            PG8_BAR; PG8_WAIT_L(0); PG8_MMA(0, 1, At, B1); PG8_BAR;
            PG8_LDA(At, 1, 1); PG8_STAGE(PG8_SA(1, 0), a3, voffA);
            PG8_BAR; PG8_WAIT_L(0); PG8_MMA(1, 0, At, B0); PG8_BAR; PG8_SCHED;
            PG8_STAGE(PG8_SB(1, 1), b3 + hstep, voffB);
            PG8_WAIT_V(6); PG8_BAR; PG8_MMA(1, 1, At, B1); PG8_BAR;
            }
        }
        if constexpr (ALIGN_EPI) { if (wr == 0) PG8_BAR; }
        if constexpr (!Epi::AFTER_DRAIN) { E(acc, cur, wr, wc, fr, fq); S.done(cur); }
        if (!has_next) break;
#pragma unroll
        for (int a = 0; a < 2; ++a)
#pragma unroll
            for (int b = 0; b < 2; ++b)
#pragma unroll
                for (int m = 0; m < 4; ++m)
#pragma unroll
                    for (int n = 0; n < 2; ++n) acc[a][b][m][n] = (f32x4){0.f, 0.f, 0.f, 0.f};
        cur = nxt; cA = nA; cB = nB; ++ui;
        if constexpr (ALIGN_EPI) { if (wr == 1) PG8_BAR; }
    }
    PG8_WAIT_V(0);
    if constexpr (!ALIGN_EPI) { if (wr == 0) PG8_BAR; }
    PG8_BAR;
    if constexpr (Epi::AFTER_DRAIN) { E.fused(acc, cur, wr, wc, fr, fq, lds, wid, lane); S.done(cur); }
#undef PG8_SA
#undef PG8_SB
#undef PG8_STAGE
#undef PG8_LDA
#undef PG8_LDB
#undef PG8_MMA
#undef PG8_WAIT_V
#undef PG8_WAIT_L
#undef PG8_BAR
#undef PG8_SCHED
}
}

#define LAS __attribute__((address_space(3)))
typedef unsigned short bf16_t;
typedef short bf16x8 __attribute__((ext_vector_type(8)));
typedef short s16x4 __attribute__((ext_vector_type(4)));
typedef short v4i16_t __attribute__((ext_vector_type(4)));
typedef float f32x2 __attribute__((ext_vector_type(2)));
typedef float f32x4 __attribute__((ext_vector_type(4)));
typedef float f32x16 __attribute__((ext_vector_type(16)));
typedef unsigned u32x2 __attribute__((ext_vector_type(2)));
typedef unsigned u32x4 __attribute__((ext_vector_type(4)));
typedef __bf16 bf16x2_t __attribute__((ext_vector_type(2)));

#ifndef PROBE_MASK
#define PROBE_MASK 0
#endif
#ifndef MK_MULTI
#define MK_MULTI 0
#endif

constexpr int MTOK = 16384, DM = 1024, DFF = 2816, SEQ = 8192, NLAYER = 4;
constexpr int PW = 512;
constexpr int YW = 1280;
constexpr float EPS = 1e-6f;
constexpr float LOG2E = 1.4426950408889634f;
constexpr float QSCALE = 0.125f * LOG2E;
constexpr size_t MiB = (size_t)1 << 20;
constexpr size_t WS_MISC = 0, WS_TAB = 2 * MiB, WS_WFWO = 3 * MiB, WS_W = 4 * MiB;
constexpr size_t WS_XF = 48 * MiB, WS_XB = 112 * MiB, WS_ACT = 144 * MiB, WS_P = 144 * MiB, WS_YCAT = 208 * MiB, WS_GP = 248 * MiB, WS_SS = 264 * MiB, WS_QC = 160 * MiB, WS_KC = 176 * MiB, WS_VC = 192 * MiB, WS_W1 = 277 * MiB, WS_END = 317 * MiB;
constexpr size_t W_GU1 = 0, W_D1 = 11534336, W_GU2 = 17301504, W_D2 = 28835840, W_IN = 34603008, W_O = 38797312;
constexpr size_t TB_64C = 0, TB_64S = 8192, TB_128C = 16384, TB_128S = 49152, TB_TWC = 81920, TB_TWS = 114688, TB_64FC = 147456, TB_64FS = 163840;
constexpr int LDS_BYTES = 139264;
constexpr int NPHASE = 1 + 8 * NLAYER + 1;
constexpr int CONV_TILE_CHUNKS = 1216, CONV_CHUNKS = CONV_TILE_CHUNKS + 128;

struct Args { const float* in[21]; float* out; unsigned char* ws; int ph_lo, ph_hi, coop, pad; };
typedef const __attribute__((address_space(4))) Args CArgs;

__device__ __forceinline__ unsigned pk2(float lo, float hi) { f32x2 v = {lo, hi}; bf16x2_t b = __builtin_convertvector(v, bf16x2_t); return __builtin_bit_cast(unsigned, b); }
__device__ __forceinline__ bf16_t bf1(float x) { return (bf16_t)(pk2(x, 0.f) & 0xffffu); }
__device__ __forceinline__ float wave_sum(float v) {
#pragma unroll
    for (int o = 1; o < 64; o <<= 1) v += __shfl_xor(v, o);
    return v;
}
__device__ __forceinline__ int fresh_tid() { int t; asm volatile("v_mov_b32 %0, %1" : "=v"(t) : "v"((int)threadIdx.x)); return t; }
__device__ __forceinline__ unsigned char* wbuf(unsigned char* ws, int l) { return ws + ((l & 1) ? WS_W1 : WS_W); }
__device__ __forceinline__ int crow(int r, int hi) { return (r & 3) + 8 * (r >> 2) + 4 * hi; }
__device__ __forceinline__ s16x4 vtr(const LAS unsigned char* p) { return __builtin_bit_cast(s16x4, __builtin_amdgcn_ds_read_tr16_b64_v4i16((LAS v4i16_t*)p)); }
__device__ __forceinline__ bf16x8 cat8(s16x4 lo, s16x4 hi) { return __builtin_shufflevector(lo, hi, 0, 1, 2, 3, 4, 5, 6, 7); }
#define MFMA32(a, b, c) __builtin_amdgcn_mfma_f32_32x32x16_bf16((a), (b), (c), 0, 0, 0)

__device__ __forceinline__ float row_rs(const float* ss, int row) {
    const f32x4* p = (const f32x4*)(ss + (size_t)row * 16); const f32x4 a = p[0], b = p[1], c = p[2], d = p[3];
    const float s = (((a.x + a.y) + (a.z + a.w)) + ((b.x + b.y) + (b.z + b.w))) + (((c.x + c.y) + (c.z + c.w)) + ((d.x + d.y) + (d.z + d.w)));
    return rsqrtf(s * (1.0f / DM) + EPS);
}
__device__ __forceinline__ void rows_rs8(const float* ss, int row0, int fq, float (&r)[8]) {
    f32x4 pv[8];
#pragma unroll
    for (int i = 0; i < 8; ++i) pv[i] = ((const f32x4*)(ss + (size_t)(row0 + (i >> 2) * 128 + (i & 3) * 16) * 16))[fq];
#pragma unroll
    for (int i = 0; i < 8; ++i) {
        float q = (pv[i].x + pv[i].y) + (pv[i].z + pv[i].w);
        q += __shfl_xor(q, 16); q += __shfl_xor(q, 32);
        r[i] = rsqrtf(q * (1.0f / DM) + EPS);
    }
}
struct EpiSwiGLU {
    static constexpr bool PERM = true, AFTER_DRAIN = false;
    bf16_t* act; const float* ss;
    __device__ __forceinline__ void operator()(const pg8::f32x4 (&acc)[2][2][4][2], const pg8::Unit& u, int wr, int wc, int fr, int fq) const {
        const int row0 = u.pm * 256 + wr * 64 + fr, col0 = u.pn * 128 + wc * 32 + 8 * fq;
        float rs[8]; rows_rs8(ss, row0, fq, rs);
#pragma unroll
        for (int ai = 0; ai < 2; ++ai)
#pragma unroll
            for (int m = 0; m < 4; ++m) {
                const int row = row0 + ai * 128 + m * 16;
                const float r = rs[ai * 4 + m];
                float o[8];
#pragma unroll
                for (int n = 0; n < 2; ++n)
#pragma unroll
                    for (int i = 0; i < 4; ++i) {
                        const float g = acc[ai][0][m][n][i] * r, up = acc[ai][1][m][n][i] * r;
                        const float sg = g * __builtin_amdgcn_rcpf(1.0f + __builtin_amdgcn_exp2f(-g * LOG2E));
                        o[4 * n + i] = sg * up;
                    }
                u32x4 w; w.x = pk2(o[0], o[1]); w.y = pk2(o[2], o[3]); w.z = pk2(o[4], o[5]); w.w = pk2(o[6], o[7]);
                *(u32x4*)(act + (size_t)row * DFF + col0) = w;
            }
    }
};
struct EpiResid {
    static constexpr bool PERM = true, AFTER_DRAIN = false;
    const float* xin; bf16_t* xl; bf16_t* xb; float* ss_out; float scale;
    __device__ __forceinline__ void operator()(const pg8::f32x4 (&acc)[2][2][4][2], const pg8::Unit& u, int wr, int wc, int fr, int fq) const {
        const int row0 = u.pm * 256 + wr * 64 + fr, col0 = u.pn * 256 + wc * 32 + 8 * fq;
#pragma unroll
        for (int ai = 0; ai < 2; ++ai)
#pragma unroll
            for (int m = 0; m < 4; ++m) {
                const int row = row0 + ai * 128 + m * 16;
                float sq = 0.f;
#pragma unroll
                for (int bj = 0; bj < 2; ++bj) {
                    const size_t off = (size_t)row * DM + col0 + bj * 128;
                    f32x4 x0, x1;
                    if (xin) { x0 = *(const f32x4*)(xin + off); x1 = *(const f32x4*)(xin + off + 4); }
                    else {
                        const u32x4 h = *(const u32x4*)(xb + off);
                        x0 = (f32x4){__uint_as_float(h.x << 16), __uint_as_float(h.x & 0xffff0000u), __uint_as_float(h.y << 16), __uint_as_float(h.y & 0xffff0000u)};
                        x1 = (f32x4){__uint_as_float(h.z << 16), __uint_as_float(h.z & 0xffff0000u), __uint_as_float(h.w << 16), __uint_as_float(h.w & 0xffff0000u)};
                    }
                    x0 = x0 + acc[ai][bj][m][0] * scale; x1 = x1 + acc[ai][bj][m][1] * scale;
                    sq += (x0.x * x0.x + x0.y * x0.y) + (x0.z * x0.z + x0.w * x0.w) + (x1.x * x1.x + x1.y * x1.y) + (x1.z * x1.z + x1.w * x1.w);
                    u32x4 w; w.x = pk2(x0.x, x0.y); w.y = pk2(x0.z, x0.w); w.z = pk2(x1.x, x1.y); w.w = pk2(x1.z, x1.w);
                    *(u32x4*)(xb + off) = w;
                }
                sq += __shfl_xor(sq, 16); sq += __shfl_xor(sq, 32);
                if (fq == 0) ss_out[(size_t)row * 16 + u.pn * 4 + wc] = sq;
            }
    }
};
struct EpiWin {
    static constexpr bool PERM = true, AFTER_DRAIN = false;
    bf16_t* P; bf16_t* QKV; const float* ss;
    __device__ __forceinline__ void operator()(const pg8::f32x4 (&acc)[2][2][4][2], const pg8::Unit& u, int wr, int wc, int fr, int fq) const {
        const int row0 = u.pm * 256 + wr * 64 + fr, cw = wc * 32 + 8 * fq;
        const float qs = (u.pn == 2 || u.pn == 3) ? QSCALE : 1.0f;
        float rs[8]; rows_rs8(ss, row0, fq, rs);
#pragma unroll
        for (int ai = 0; ai < 2; ++ai)
#pragma unroll
            for (int m = 0; m < 4; ++m) {
                const int row = row0 + ai * 128 + m * 16;
                const float r = rs[ai * 4 + m] * qs;
#pragma unroll
                for (int bj = 0; bj < 2; ++bj) {
                    const f32x4 v0 = acc[ai][bj][m][0] * r, v1 = acc[ai][bj][m][1] * r;
                    u32x4 w; w.x = pk2(v0.x, v0.y); w.y = pk2(v0.z, v0.w); w.z = pk2(v1.x, v1.y); w.w = pk2(v1.z, v1.w);
                    if (u.pn < 2) *(u32x4*)(P + (size_t)row * PW + u.pn * 256 + bj * 128 + cw) = w;
                    else { const int sect = (u.pn - 2) >> 1, h = ((u.pn & 1) << 1) + bj;
                        *(u32x4*)(QKV + (size_t)sect * (8u << 20) + ((size_t)(((row >> 13) * 4 + h) * SEQ + (row & (SEQ - 1)))) * 128 + cw) = w; }
                }
            }
    }
};

__device__ __forceinline__ void conv_chunk(CArgs* a, int l, int chunk, LAS unsigned char* lds);
__device__ __forceinline__ void phase_p0(CArgs* a, LAS unsigned char* lds) {
    const int tid = fresh_tid(), lane = tid & 63, wave = tid >> 6;
    unsigned char* ws = a->ws;
    float* xf = (float*)(ws + WS_XF); bf16_t* xb = (bf16_t*)(ws + WS_XB); float* ss = (float*)(ws + WS_SS);
    const float* x = a->in[0];
    for (int row0 = blockIdx.x * 8 + wave; row0 < MTOK; row0 += gridDim.x * 16) {
        const int row1 = row0 + gridDim.x * 8; const bool has1 = row1 < MTOK; const int r1 = has1 ? row1 : row0;
        const f32x4* xr0 = (const f32x4*)(x + (size_t)row0 * DM) + lane; const f32x4* xr1 = (const f32x4*)(x + (size_t)r1 * DM) + lane;
        f32x4 v0[4], v1[4]; float s0 = 0.f, s1 = 0.f;
#pragma unroll
        for (int j = 0; j < 4; ++j) { v0[j] = xr0[64 * j]; v1[j] = xr1[64 * j]; }
#pragma unroll
        for (int j = 0; j < 4; ++j) { s0 += (v0[j].x * v0[j].x + v0[j].y * v0[j].y) + (v0[j].z * v0[j].z + v0[j].w * v0[j].w); s1 += (v1[j].x * v1[j].x + v1[j].y * v1[j].y) + (v1[j].z * v1[j].z + v1[j].w * v1[j].w); }
        s0 = wave_sum(s0); s1 = wave_sum(s1);
        u32x2* bo0 = (u32x2*)(xb + (size_t)row0 * DM) + lane; u32x2* bo1 = (u32x2*)(xb + (size_t)r1 * DM) + lane;
#pragma unroll
        for (int j = 0; j < 4; ++j) { u32x2 w; w.x = pk2(v0[j].x, v0[j].y); w.y = pk2(v0[j].z, v0[j].w); bo0[64 * j] = w; }
        if (lane < 16) ss[(size_t)row0 * 16 + lane] = (lane == 0) ? s0 : 0.f;
        if (has1) {
#pragma unroll
            for (int j = 0; j < 4; ++j) { u32x2 w; w.x = pk2(v1[j].x, v1[j].y); w.y = pk2(v1[j].z, v1[j].w); bo1[64 * j] = w; }
            if (lane < 16) ss[(size_t)row1 * 16 + lane] = (lane == 0) ? s1 : 0.f;
        }
    }
    const int gtid = blockIdx.x * 512 + tid, NT = gridDim.x * 512;
    unsigned char* tb = ws + WS_TAB;
    for (int i = gtid; i < 4096; i += NT) {
        const int k = i >> 6, s = i & 63, idx = (k * s) & 63;
        const float c = cospif((float)idx * (2.0f / 64.0f)), sn = sinpif((float)idx * (2.0f / 64.0f));
        ((bf16_t*)(tb + TB_64C))[i] = bf1(c); ((bf16_t*)(tb + TB_64S))[i] = bf1(sn);
        ((float*)(tb + TB_64FC))[i] = c; ((float*)(tb + TB_64FS))[i] = sn;
    }
    for (int i = gtid; i < 16384; i += NT) {
        const int k = i >> 7, s = i & 127, idx = (k * s) & 127;
        ((bf16_t*)(tb + TB_128C))[i] = bf1(cospif((float)idx * (2.0f / 128.0f))); ((bf16_t*)(tb + TB_128S))[i] = bf1(sinpif((float)idx * (2.0f / 128.0f)));
    }
    for (int i = gtid; i < 8192; i += NT) {
        const int s2 = i >> 6, k1 = i & 63, idx = s2 * k1;
        ((float*)(tb + TB_TWC))[i] = cospif((float)idx * (2.0f / 8192.0f)); ((float*)(tb + TB_TWS))[i] = sinpif((float)idx * (2.0f / 8192.0f));
    }
    for (int chunk = blockIdx.x; chunk < CONV_CHUNKS; chunk += gridDim.x) conv_chunk(a, 0, chunk, lds);
    if (blockIdx.x == 0 && tid < 8) ((unsigned*)(ws + WS_MISC + 256))[tid] = 0u;
    if (blockIdx.x == 0 && wave == 0) {
        for (int l = 0; l < NLAYER; ++l) {
            const float p1 = a->in[10][l * 64 + lane] * a->in[11][l * 64 + lane], p2 = a->in[12][l * 64 + lane] * a->in[13][l * 64 + lane];
            const float s1 = wave_sum(p1), s2 = wave_sum(p2);
            if (lane == 0) ((float*)(ws + WS_MISC))[l] = expf(s1) - expf(s2) + (0.8f - 0.6f * expf(-0.3f * (float)l));
        }
    }
}

__device__ __forceinline__ void conv_wtile(const float* src, int ld_src, int k0, int n0, const float* gain, bf16_t* dst, int ld_dst, int kofs, int nmode, LAS float* scr, int lane) {
    float v[32];
    const float* sp0 = src + (size_t)(k0 + (lane >> 5)) * ld_src + n0 + (lane & 31);
#pragma unroll
    for (int i = 0; i < 32; ++i) v[i] = sp0[(size_t)(2 * i) * ld_src];
#pragma unroll
    for (int i = 0; i < 32; ++i) scr[(2 * i + (lane >> 5)) * 33 + (lane & 31)] = v[i];
    asm volatile("s_waitcnt lgkmcnt(0)" ::: "memory");
    const int c = lane & 7;
    f32x4 g0 = {1.f, 1.f, 1.f, 1.f}, g1 = {1.f, 1.f, 1.f, 1.f};
    if (gain) { g0 = *(const f32x4*)(gain + k0 + 8 * c); g1 = *(const f32x4*)(gain + k0 + 8 * c + 4); }
#pragma unroll
    for (int j = 0; j < 4; ++j) {
        const int nl = (lane >> 3) + 8 * j, n = n0 + nl;
        const int np = (nmode == 0) ? n : (256 * (n >> 7) + (n & 127) + (nmode == 2 ? 128 : 0));
        const LAS float* sp = scr + (8 * c) * 33 + nl;
        u32x4 o; o.x = pk2(sp[0] * g0.x, sp[33] * g0.y); o.y = pk2(sp[2 * 33] * g0.z, sp[3 * 33] * g0.w); o.z = pk2(sp[4 * 33] * g1.x, sp[5 * 33] * g1.y); o.w = pk2(sp[6 * 33] * g1.z, sp[7 * 33] * g1.w);
        *(u32x4*)(dst + (size_t)np * ld_dst + kofs + k0 + 8 * c) = o;
    }
    asm volatile("s_waitcnt lgkmcnt(0)" ::: "memory");
}
__device__ __forceinline__ void conv_chunk(CArgs* a, int l, int chunk, LAS unsigned char* lds) {
    const int tid = fresh_tid(), lane = tid & 63, wave = tid >> 6;
    if (chunk < CONV_TILE_CHUNKS) {
        LAS float* scr = (LAS float*)(lds + wave * 8448);
        unsigned char* wb = wbuf(a->ws, l);
        const size_t FW = (size_t)DM * DFF;
        const int it = chunk * 8 + wave;
        if (it < 8448) {
            const int f = it / 4224, r = it % 4224;
            const float* gn = a->in[f ? 16 : 1] + l * DM;
            if (r < 2816) {
                const int up = r / 1408, t = r % 1408, kt = t / 88, nt = t % 88;
                const float* src = a->in[f ? (up ? 18 : 17) : (up ? 3 : 2)] + (size_t)l * FW;
                conv_wtile(src, DFF, kt * 64, nt * 32, gn, (bf16_t*)(wb + (f ? W_GU2 : W_GU1)), DM, 0, up ? 2 : 1, scr, lane);
            } else {
                const int t = r - 2816, kt = t / 32, nt = t % 32;
                const float* src = a->in[f ? 19 : 4] + (size_t)l * FW;
                conv_wtile(src, DM, kt * 64, nt * 32, nullptr, (bf16_t*)(wb + (f ? W_D2 : W_D1)), DFF, 0, 0, scr, lane);
            }
        } else if (it < 9472) {
            const int t = it - 8448, kt = t / 64, nt = t % 64;
            conv_wtile(a->in[6] + (size_t)l * DM * 2048, 2048, kt * 64, nt * 32, a->in[5] + l * DM, (bf16_t*)(wb + W_IN), DM, 0, 0, scr, lane);
        } else {
            const int t = it - 9472, kt = t / 32, nt = t % 32;
            conv_wtile(a->in[15] + (size_t)l * DM * DM + (size_t)512 * DM, DM, kt * 64, nt * 32, nullptr, (bf16_t*)(wb + W_O), YW, 768, 0, scr, lane);
        }
    } else {
        const float* fw = a->in[9] + (size_t)l * 256 * 256; const float* wo = a->in[15] + (size_t)l * DM * DM + (size_t)256 * DM;
        float* wfwo = (float*)(a->ws + WS_WFWO);
        const int item = __builtin_amdgcn_readfirstlane((chunk - CONV_TILE_CHUNKS) * 8 + wave), rb = item >> 8, n0 = (item & 255) * 4, r = rb * 64 + lane;
        float acc0 = 0.f, acc1 = 0.f, acc2 = 0.f, acc3 = 0.f;
#pragma unroll 1
        for (int cc = 0; cc < 4; ++cc) {
            f32x4 av[16];
#pragma unroll
            for (int i = 0; i < 16; ++i) av[i] = *(const f32x4*)(fw + (size_t)r * 256 + cc * 64 + 4 * i);
            const float* B = wo + (size_t)(cc * 64) * DM + n0;
#pragma unroll
            for (int i = 0; i < 16; ++i)
#pragma unroll
                for (int e = 0; e < 4; ++e) {
                    const f32x4 bv = *(const f32x4*)(B + (size_t)(4 * i + e) * DM);
                    acc0 = fmaf(av[i][e], bv.x, acc0); acc1 = fmaf(av[i][e], bv.y, acc1); acc2 = fmaf(av[i][e], bv.z, acc2); acc3 = fmaf(av[i][e], bv.w, acc3);
                }
        }
        *(f32x4*)(wfwo + (size_t)r * DM + n0) = (f32x4){acc0, acc1, acc2, acc3};
    }
}
__device__ __forceinline__ void fold_wout(CArgs* a, int l) {
    const int tid = fresh_tid(), lane = tid & 63, wave = tid >> 6;
    const float* pw = a->in[7] + (size_t)l * 4 * 64 * 64; const float* ps = a->in[8] + l * 256; const float* wo = a->in[15] + (size_t)l * DM * DM;
    const float* wfwo = (const float*)(a->ws + WS_WFWO);
    const float* fc = (const float*)(a->ws + WS_TAB + TB_64FC); const float* fs = (const float*)(a->ws + WS_TAB + TB_64FS);
    bf16_t* wot = (bf16_t*)(wbuf(a->ws, l) + W_O);
    for (int item = __builtin_amdgcn_readfirstlane(blockIdx.x * 8 + wave); item < 3072; item += gridDim.x * 8) {
        const int sec = item >> 10, g = (item >> 8) & 3, n0 = (item & 255) * 4;
        const float* arow = (sec == 0) ? pw + (g * 64 + lane) * 64 : ((sec == 1) ? fc + lane * 64 : fs + lane * 64);
        const float* B = ((sec == 0) ? wo : wfwo) + (size_t)(g * 64) * DM + n0;
        float acc0 = 0.f, acc1 = 0.f, acc2 = 0.f, acc3 = 0.f;
#pragma unroll 4
        for (int d4 = 0; d4 < 16; ++d4) {
            f32x4 av = *(const f32x4*)(arow + 4 * d4);
            if (sec == 0) av = av * *(const f32x4*)(ps + g * 64 + 4 * d4);
#pragma unroll
            for (int e = 0; e < 4; ++e) {
                const f32x4 bv = *(const f32x4*)(B + (size_t)(4 * d4 + e) * DM);
                acc0 = fmaf(av[e], bv.x, acc0); acc1 = fmaf(av[e], bv.y, acc1); acc2 = fmaf(av[e], bv.z, acc2); acc3 = fmaf(av[e], bv.w, acc3);
            }
        }
        const float sc = (sec == 0) ? 1.0f : ((sec == 1) ? 0.125f : -0.125f);
        bf16_t* op = wot + (size_t)n0 * YW + sec * 256 + g * 64 + lane;
        op[0] = bf1(acc0 * sc); op[YW] = bf1(acc1 * sc); op[2 * YW] = bf1(acc2 * sc); op[3 * YW] = bf1(acc3 * sc);
    }
}

__device__ __forceinline__ void pool_unit(const bf16_t* P, bf16_t* ycat, int unit) {
    const int tid = fresh_tid(), chunk = tid & 31, trow = tid >> 5, g = chunk >> 3, w = 2 << g, left = w >> 1, right = w - 1 - left;
#pragma unroll 1
    for (int i = 0; i < 4; ++i) {
        const int t = unit * 64 + trow + 16 * i, b = t >> 13, s = t & (SEQ - 1);
        const int lo = max(s - left, 0), hi = min(s + right + 1, SEQ);
        u32x4 v[16];
#pragma unroll
        for (int j = 0; j < 16; ++j) { const int p = min(max(s - 8 + j, 0), SEQ - 1); v[j] = *(const u32x4*)(P + (size_t)(b * SEQ + p) * PW + chunk * 8); }
        float acc[8];
#pragma unroll
        for (int e = 0; e < 8; ++e) acc[e] = 0.f;
#pragma unroll
        for (int j = 0; j < 16; ++j) {
            const int p = s - 8 + j; const float wgt = (p >= lo && p < hi) ? 1.0f : 0.0f;
            acc[0] = fmaf(wgt, __uint_as_float(v[j].x << 16), acc[0]); acc[1] = fmaf(wgt, __uint_as_float(v[j].x & 0xffff0000u), acc[1]);
            acc[2] = fmaf(wgt, __uint_as_float(v[j].y << 16), acc[2]); acc[3] = fmaf(wgt, __uint_as_float(v[j].y & 0xffff0000u), acc[3]);
            acc[4] = fmaf(wgt, __uint_as_float(v[j].z << 16), acc[4]); acc[5] = fmaf(wgt, __uint_as_float(v[j].z & 0xffff0000u), acc[5]);
            acc[6] = fmaf(wgt, __uint_as_float(v[j].w << 16), acc[6]); acc[7] = fmaf(wgt, __uint_as_float(v[j].w & 0xffff0000u), acc[7]);
        }
        const u32x4 c = v[8];
        const float ic = 1.0f / (float)(hi - lo);
        u32x4 o;
        o.x = pk2(acc[0] * ic - __uint_as_float(c.x << 16), acc[1] * ic - __uint_as_float(c.x & 0xffff0000u));
        o.y = pk2(acc[2] * ic - __uint_as_float(c.y << 16), acc[3] * ic - __uint_as_float(c.y & 0xffff0000u));
        o.z = pk2(acc[4] * ic - __uint_as_float(c.z << 16), acc[5] * ic - __uint_as_float(c.z & 0xffff0000u));
        o.w = pk2(acc[6] * ic - __uint_as_float(c.w << 16), acc[7] * ic - __uint_as_float(c.w & 0xffff0000u));
        *(u32x4*)(ycat + (size_t)t * YW + chunk * 8) = o;
    }
}

__device__ __forceinline__ void fa_unit(LAS unsigned char* lds, const bf16_t* P, bf16_t* GP, const unsigned char* tb, int b, int s2) {
    const int tid = fresh_tid(), lane = tid & 63, r32 = lane & 31, hi = lane >> 5, wid = __builtin_amdgcn_readfirstlane(tid >> 6);
#pragma unroll
    for (int i = 0; i < 4; ++i) {
        const int idx = tid + 512 * i, s1 = idx >> 5, ch = idx & 31;
        const u32x4 v = *(const u32x4*)(P + (size_t)(b * SEQ + 128 * s1 + s2) * PW + 256 + ch * 8);
        *(LAS u32x4*)(lds + (ch >> 2) * 4096 + s1 * 64 + (ch & 3) * 16) = v;
    }
    __syncthreads();
    const int i16 = lane & 15, q = i16 >> 2, p = i16 & 3, blk = (lane >> 4) & 1;
    const LAS unsigned char* bp = lds + wid * 4096 + (8 * hi + q) * 64 + blk * 32 + p * 8;
    bf16x8 bfr[4];
#pragma unroll
    for (int s = 0; s < 4; ++s) bfr[s] = cat8(vtr(bp + s * 1024), vtr(bp + s * 1024 + 256));
    const bf16_t* T64c = (const bf16_t*)(tb + TB_64C); const bf16_t* T64s = (const bf16_t*)(tb + TB_64S);
    const float* twc = (const float*)(tb + TB_TWC) + s2 * 64; const float* tws = (const float*)(tb + TB_TWS) + s2 * 64;
#pragma unroll
    for (int mt = 0; mt < 2; ++mt) {
        f32x16 gr, gs;
#pragma unroll
        for (int r = 0; r < 16; ++r) { gr[r] = 0.f; gs[r] = 0.f; }
#pragma unroll
        for (int s = 0; s < 4; ++s) {
            const bf16x8 ac = *(const bf16x8*)(T64c + (32 * mt + r32) * 64 + 16 * s + 8 * hi);
            const bf16x8 as = *(const bf16x8*)(T64s + (32 * mt + r32) * 64 + 16 * s + 8 * hi);
            gr = MFMA32(ac, bfr[s], gr); gs = MFMA32(as, bfr[s], gs);
        }
#pragma unroll
        for (int r = 0; r < 16; ++r) {
            const int k1 = 32 * mt + crow(r, hi);
            const float c = twc[k1], sn = tws[k1], Gr = gr[r], Gi = -gs[r];
            const float pr = (Gr * c + Gi * sn) * 0.125f, pi = (Gi * c - Gr * sn) * 0.125f;
            bf16_t* gp = GP + ((size_t)((b * 64 + k1) * 128 + s2) * 2) * 256 + wid * 32 + r32;
            gp[0] = bf1(pr); gp[256] = bf1(pi);
        }
    }
    __syncthreads();
}
__device__ __forceinline__ void fc_unit(LAS unsigned char* lds, const bf16_t* GP, bf16_t* ycat, const unsigned char* tb, int b, int k1, int chalf) {
    const int tid = fresh_tid(), lane = tid & 63, r32 = lane & 31, hi = lane >> 5, wid = __builtin_amdgcn_readfirstlane(tid >> 6);
    const bf16_t* gsrc = GP + (size_t)(b * 64 + k1) * 128 * 2 * 256 + chalf * 128;
#pragma unroll
    for (int i = 0; i < 8; ++i) {
        const int idx = tid + 512 * i, row = idx >> 4, ch = idx & 15, s2 = row >> 1, ri = row & 1;
        const u32x4 v = *(const u32x4*)(gsrc + (size_t)row * 256 + ch * 8);
        *(LAS u32x4*)(lds + ((ch >> 2) * 2 + ri) * 8192 + s2 * 64 + (ch & 3) * 16) = v;
    }
    __syncthreads();
    const int cblk = wid & 3, kh = wid >> 2;
    const int i16 = lane & 15, q = i16 >> 2, p = i16 & 3, blk = (lane >> 4) & 1;
    const LAS unsigned char* bpr = lds + (cblk * 2) * 8192 + (8 * hi + q) * 64 + blk * 32 + p * 8;
    const LAS unsigned char* bpi = bpr + 8192;
    const bf16_t* T128c = (const bf16_t*)(tb + TB_128C); const bf16_t* T128s = (const bf16_t*)(tb + TB_128S);
    f32x16 xr[2], sf[2];
#pragma unroll
    for (int mt = 0; mt < 2; ++mt)
#pragma unroll
        for (int r = 0; r < 16; ++r) { xr[mt][r] = 0.f; sf[mt][r] = 0.f; }
#pragma unroll
    for (int s = 0; s < 8; ++s) {
        const bf16x8 br = cat8(vtr(bpr + s * 1024), vtr(bpr + s * 1024 + 256));
        const bf16x8 bi = cat8(vtr(bpi + s * 1024), vtr(bpi + s * 1024 + 256));
#pragma unroll
        for (int mt = 0; mt < 2; ++mt) {
            const int krow = 32 * (2 * kh + mt) + r32;
            const bf16x8 ac = *(const bf16x8*)(T128c + krow * 128 + 16 * s + 8 * hi);
            const bf16x8 as = *(const bf16x8*)(T128s + krow * 128 + 16 * s + 8 * hi);
            const bf16x8 nc = ac ^ (short)0x8000;
            xr[mt] = MFMA32(ac, br, xr[mt]); xr[mt] = MFMA32(as, bi, xr[mt]);
            sf[mt] = MFMA32(as, br, sf[mt]); sf[mt] = MFMA32(nc, bi, sf[mt]);
        }
    }
    const float sc = 0.08838834764831845f;
#pragma unroll
    for (int mt = 0; mt < 2; ++mt)
#pragma unroll
        for (int r = 0; r < 16; ++r) {
            const int k2 = 32 * (2 * kh + mt) + crow(r, hi), k = k1 + 64 * k2;
            bf16_t* yp = ycat + (size_t)(b * SEQ + k) * YW + 256 + chalf * 128 + cblk * 32 + r32;
            yp[0] = bf1(xr[mt][r] * sc); yp[256] = bf1(sf[mt][r] * sc);
        }
    __syncthreads();
}

constexpr int AT_KB = 17408, AT_VS = 4096, AT_VB = 4 * AT_VS, AT_VOFF = 2 * AT_KB, AT_MISC = AT_VOFF + 3 * AT_VB;
__device__ __forceinline__ float wave_max(float v) {
#pragma unroll
    for (int o = 1; o < 64; o <<= 1) v = fmaxf(v, __shfl_xor(v, o));
    return v;
}
__device__ __forceinline__ float wave_min(float v) {
#pragma unroll
    for (int o = 1; o < 64; o <<= 1) v = fminf(v, __shfl_xor(v, o));
    return v;
}
#pragma float_control(push)
#pragma float_control(precise, off)
__device__ __forceinline__ float rowmax32(const f32x16& a, const f32x16& b) {
    float m0 = __builtin_fmaxf(a[0], b[0]), m1 = __builtin_fmaxf(a[1], b[1]);
#pragma unroll
    for (int r = 2; r < 16; r += 2) { m0 = __builtin_fmaxf(m0, __builtin_fmaxf(a[r], b[r])); m1 = __builtin_fmaxf(m1, __builtin_fmaxf(a[r + 1], b[r + 1])); }
    return __builtin_fmaxf(m0, m1);
}
#pragma float_control(pop)
__device__ __forceinline__ float bflo(unsigned u) { return __uint_as_float(u << 16); }
__device__ __forceinline__ float bfhi(unsigned u) { return __uint_as_float(u & 0xffff0000u); }
__device__ __forceinline__ void knorm_items(const bf16_t* KC, float* knmax) {
    const int tid = fresh_tid(), lane = tid & 63, wave = tid >> 6;
    for (int item = blockIdx.x * 8 + wave; item < 2048; item += gridDim.x * 8) {
        const int tile = item & 127, j = (item >> 7) & 1, h = (item >> 8) & 3, b = item >> 10;
        const bf16_t* kp = KC + ((size_t)((b * 4 + h) * SEQ + tile * 64 + lane)) * 128 + j * 64;
        float s = 0.f;
#pragma unroll
        for (int i = 0; i < 8; ++i) {
            const u32x4 v = *(const u32x4*)(kp + 8 * i);
            s += (bflo(v.x) * bflo(v.x) + bfhi(v.x) * bfhi(v.x)) + (bflo(v.y) * bflo(v.y) + bfhi(v.y) * bfhi(v.y)) + (bflo(v.z) * bflo(v.z) + bfhi(v.z) * bfhi(v.z)) + (bflo(v.w) * bflo(v.w) + bfhi(v.w) * bfhi(v.w));
        }
        const float n = wave_max(sqrtf(s));
        if (lane == 0) knmax[item] = n;
    }
}
__device__ __forceinline__ void attn_unit(LAS unsigned char* lds, const bf16_t* QC, bf16_t* ycat, const float* knmax, int b, int h, int qb, float lam, float outscale, const float* hn) {
    const int tid = fresh_tid(), lane = tid & 63, r32 = lane & 31, hi = lane >> 5, wid = __builtin_amdgcn_readfirstlane(tid >> 6);
    const int j = wid & 1, qs = wid >> 1, q0 = qb * 128 + qs * 32;
    const size_t rowbase = (size_t)b * SEQ;
    LAS float* knl = (LAS float*)(lds + AT_MISC); LAS float* red = knl + 256;
    bf16x8 qf[4];
    {
        const bf16_t* Qp = QC + ((size_t)((b * 4 + h) * SEQ + q0 + r32)) * 128 + j * 64 + 8 * hi;
#pragma unroll
        for (int s = 0; s < 4; ++s) qf[s] = *(const bf16x8*)(Qp + 16 * s);
        float q2 = 0.f;
#pragma unroll
        for (int s = 0; s < 4; ++s) { const u32x4 w = __builtin_bit_cast(u32x4, qf[s]);
            q2 += (bflo(w.x) * bflo(w.x) + bfhi(w.x) * bfhi(w.x)) + (bflo(w.y) * bflo(w.y) + bfhi(w.y) * bfhi(w.y)) + (bflo(w.z) * bflo(w.z) + bfhi(w.z) * bfhi(w.z)) + (bflo(w.w) * bflo(w.w) + bfhi(w.w) * bfhi(w.w)); }
        q2 += __shfl_xor(q2, 32);
        const float qn = wave_max(sqrtf(q2));
        if (lane == 0) red[wid] = qn;
        if (tid < 256) knl[tid] = knmax[(b * 4 + h) * 256 + tid];
    }
    const int key0 = tid >> 4, ch = tid & 15;
    const bf16_t* Ksrc = QC + (8u << 20) + ((size_t)((b * 4 + h) * SEQ)) * 128 + tid * 8;
    const int kdst = key0 * 272 + ch * 16, vdst = AT_VOFF + (ch >> 2) * AT_VS + key0 * 64 + (ch & 3) * 16;
    u32x4 ska0, ska1, sva0, sva1;
#define AT_LOAD(S, t) do { const bf16_t* kp_ = Ksrc + (size_t)(t) * 8192; sk##S##0 = *(const u32x4*)kp_; sk##S##1 = *(const u32x4*)(kp_ + 4096); sv##S##0 = *(const u32x4*)(kp_ + (8u << 20)); sv##S##1 = *(const u32x4*)(kp_ + (8u << 20) + 4096); } while (0)
#define AT_STORE(S, kb_, vb_) do { *(LAS u32x4*)(lds + (kb_) * AT_KB + kdst) = sk##S##0; *(LAS u32x4*)(lds + (kb_) * AT_KB + kdst + 32 * 272) = sk##S##1; \
        *(LAS u32x4*)(lds + (vb_) * AT_VB + vdst) = sv##S##0; *(LAS u32x4*)(lds + (vb_) * AT_VB + vdst + 32 * 64) = sv##S##1; } while (0)
    f32x16 o[4];
#pragma unroll
    for (int et = 0; et < 4; ++et)
#pragma unroll
        for (int r = 0; r < 16; ++r) o[et][r] = 0.f;
    float m = -64.0f, l = 0.f;
    const float cb = exp2f(-2.0f * (float)(h + 1)) * LOG2E;
    const float qpos = (float)(q0 + r32);
    const int i16 = lane & 15, tq = i16 >> 2, tp = i16 & 3, blk = (lane >> 4) & 1;
    const int koff = r32 * 272 + (64 * j + 8 * hi) * 2;
    const int voff = AT_VOFF + (4 * hi + tq) * 64 + blk * 32 + tp * 8;
    const int td0 = 2 * qb;
    u32x4 ab0 = {0u, 0u, 0u, 0u}, ab1 = {0u, 0u, 0u, 0u};
    if (hi == 0) {
        const float c0 = cb * (float)r32, c1 = cb * (float)(r32 + 32);
        const unsigned h0 = pk2(c0, 0.f) & 0xffffu, h1 = pk2(c1, 0.f) & 0xffffu;
        ab0.x = h0 | (pk2(c0 - __uint_as_float(h0 << 16), 0.f) << 16);
        ab1.x = h1 | (pk2(c1 - __uint_as_float(h1 << 16), 0.f) << 16);
    }
    const bool grpB = wid >= 4;
    bf16x8 pa[4];
#pragma unroll
    for (int ks = 0; ks < 4; ++ks) pa[ks] = (bf16x8){0, 0, 0, 0, 0, 0, 0, 0};
#define AT_SEQ(i) ((i) < 2 ? td0 + (i) : (((i) - 2 < td0) ? td0 - 1 - ((i) - 2) : (i)))
#define SB() __builtin_amdgcn_sched_barrier(0)
#define AT_VRD(dst, ks) do { _Pragma("unroll") for (int et = 0; et < 4; ++et) dst[et] = cat8(vtr(vp_ + et * AT_VS + (ks) * 1024), vtr(vp_ + et * AT_VS + (ks) * 1024 + 512)); } while (0)
#define AT_VMM(src, ks) do { _Pragma("unroll") for (int et = 0; et < 4; ++et) o[et] = MFMA32(src[et], pa[ks], o[et]); } while (0)
#define AT_PV(vbuf) do { const LAS unsigned char* vp_ = lds + (vbuf) * AT_VB + voff; \
        _Pragma("unroll") for (int ks = 0; ks < 4; ++ks) _Pragma("unroll") for (int et = 0; et < 4; ++et) { \
            const bf16x8 vf_ = cat8(vtr(vp_ + et * AT_VS + ks * 1024), vtr(vp_ + et * AT_VS + ks * 1024 + 512)); o[et] = MFMA32(vf_, pa[ks], o[et]); } } while (0)
    int T = td0;
    AT_LOAD(a, T); AT_STORE(a, 0, 0);
    __syncthreads();
    const float qmax0 = fmaxf(fmaxf(red[0], red[2]), fmaxf(red[4], red[6])), qmax1 = fmaxf(fmaxf(red[1], red[3]), fmaxf(red[5], red[7]));
    float thr0 = -3e38f, thr1 = -3e38f;
    int kbuf = 0, vbuf = 0, vprev = 0, i = 0;
#pragma unroll 1
    for (;;) {
        int in = i + 1, Tn = -1;
        while (in < SEQ / 64) {
            const int Tc = AT_SEQ(in);
            if (in < 3) { Tn = Tc; break; }
            const float dmin = (Tc < td0) ? (float)(128 * qb - 64 * Tc - 63) : (float)(64 * Tc - 128 * qb - 127);
            if (qmax0 * knl[Tc] - cb * dmin + 1.0f >= thr0 || qmax1 * knl[128 + Tc] - cb * dmin + 1.0f >= thr1) { Tn = Tc; break; }
            ++in;
        }
        if (Tn >= 0) AT_LOAD(a, Tn);
        if (grpB && i > 0) AT_PV(vprev);
        f32x16 S0, S1;
        const bool offd = (i >= 2);
        float tadd = 0.f;
        u32x4 bb = {0u, 0u, 0u, 0u};
        if (offd) { const bool left = T < td0; bb.x = (hi == 0) ? (left ? 0x3F803F80u : 0xBF80BF80u) : 0u; const float tt = cb * ((float)(64 * T) - qpos); tadd = left ? tt : -tt; }
        {
            const float c0 = tadd - m;
#pragma unroll
            for (int r = 0; r < 16; ++r) { S0[r] = c0; S1[r] = c0; }
            const LAS unsigned char* kp = lds + kbuf * AT_KB + koff;
#pragma unroll
            for (int s = 0; s < 4; ++s) {
                const bf16x8 k0 = *(const LAS bf16x8*)(kp + s * 32), k1 = *(const LAS bf16x8*)(kp + 32 * 272 + s * 32);
                S0 = MFMA32(k0, qf[s], S0); S1 = MFMA32(k1, qf[s], S1);
            }
            S0 = MFMA32(__builtin_bit_cast(bf16x8, ab0), __builtin_bit_cast(bf16x8, bb), S0); S1 = MFMA32(__builtin_bit_cast(bf16x8, ab1), __builtin_bit_cast(bf16x8, bb), S1);
        }
        if (!offd) {
            const float kb = (float)(T * 64 + 4 * hi) - qpos;
#pragma unroll
            for (int r = 0; r < 16; ++r) {
                const float d0 = kb + (float)((r & 3) + 8 * (r >> 2));
                S0[r] = fmaf(-cb, fabsf(d0), S0[r]); S1[r] = fmaf(-cb, fabsf(d0 + 32.0f), S1[r]);
            }
        }
        {
            float mt = rowmax32(S0, S1);
            { const auto sw_ = __builtin_amdgcn_permlane32_swap(__float_as_uint(mt), __float_as_uint(mt), false, false); mt = fmaxf(__uint_as_float(sw_[0]), __uint_as_float(sw_[1])); }
            if (__any(mt > 0.f)) {
                const float dl = fmaxf(mt, 0.f), f = __builtin_amdgcn_exp2f(-dl);
                l *= f; m += dl;
#pragma unroll
                for (int et = 0; et < 4; ++et) o[et] = o[et] * f;
                S0 = S0 - dl; S1 = S1 - dl;
            }
        }
        f32x2 ls2 = {0.f, 0.f};
#pragma unroll
        for (int r = 0; r < 16; r += 2) {
            S0[r] = __builtin_amdgcn_exp2f(S0[r]); S0[r + 1] = __builtin_amdgcn_exp2f(S0[r + 1]); S1[r] = __builtin_amdgcn_exp2f(S1[r]); S1[r + 1] = __builtin_amdgcn_exp2f(S1[r + 1]);
            ls2 = ls2 + (f32x2){S0[r], S0[r + 1]}; ls2 = ls2 + (f32x2){S1[r], S1[r + 1]};
        }
        l += ls2.x + ls2.y;
        { u32x4 w;
          w.x = pk2(S0[0], S0[1]); w.y = pk2(S0[2], S0[3]); w.z = pk2(S0[4], S0[5]); w.w = pk2(S0[6], S0[7]); pa[0] = __builtin_bit_cast(bf16x8, w);
          w.x = pk2(S0[8], S0[9]); w.y = pk2(S0[10], S0[11]); w.z = pk2(S0[12], S0[13]); w.w = pk2(S0[14], S0[15]); pa[1] = __builtin_bit_cast(bf16x8, w);
          w.x = pk2(S1[0], S1[1]); w.y = pk2(S1[2], S1[3]); w.z = pk2(S1[4], S1[5]); w.w = pk2(S1[6], S1[7]); pa[2] = __builtin_bit_cast(bf16x8, w);
          w.x = pk2(S1[8], S1[9]); w.y = pk2(S1[10], S1[11]); w.z = pk2(S1[12], S1[13]); w.w = pk2(S1[14], S1[15]); pa[3] = __builtin_bit_cast(bf16x8, w); }
        if (!grpB) AT_PV(vbuf);
        if (i == 1) { const float wm = wave_min(m > -64.0f ? m : -3e38f); if (lane == 0) red[8 + wid] = wm; }
        const int vnext = (vbuf == 2) ? 0 : vbuf + 1;
        if (Tn >= 0) AT_STORE(a, kbuf ^ 1, vnext);
        __syncthreads();
        if (i == 1) { thr0 = fminf(fminf(red[8], red[10]), fminf(red[12], red[14])) - 41.0f; thr1 = fminf(fminf(red[9], red[11]), fminf(red[13], red[15])) - 41.0f; }
        vprev = vbuf;
        if (Tn < 0) break;
        i = in; T = Tn; kbuf ^= 1; vbuf = vnext;
    }
    if (grpB) AT_PV(vprev);
    __syncthreads();
#undef AT_PV
#undef AT_VRD
#undef AT_VMM
#undef SB
#undef AT_LOAD
#undef AT_STORE
#undef AT_SEQ
    l += __shfl_xor(l, 32);
    float inv = 1.0f / l; if (j == 1) inv *= lam;
    LAS float* xb = (LAS float*)lds + qs * 4096;
    if (j == 1) {
#pragma unroll
        for (int et = 0; et < 4; ++et)
#pragma unroll
            for (int r = 0; r < 16; ++r) xb[(32 * et + crow(r, hi)) * 32 + r32] = o[et][r] * inv;
    }
    __syncthreads();
    if (j == 0) {
        float sq = 0.f;
#pragma unroll
        for (int et = 0; et < 4; ++et)
#pragma unroll
            for (int r = 0; r < 16; ++r) { const float d = o[et][r] * inv - xb[(32 * et + crow(r, hi)) * 32 + r32]; o[et][r] = d; sq += d * d; }
        sq += __shfl_xor(sq, 32);
        const float rn = rsqrtf(sq * (1.0f / 128.0f) + EPS) * outscale;
        bf16_t* yo = ycat + (rowbase + q0 + r32) * YW + 768 + h * 128;
#pragma unroll
        for (int et = 0; et < 4; ++et)
#pragma unroll
            for (int g = 0; g < 4; ++g) {
                const int e0 = 32 * et + 8 * g + 4 * hi;
                const f32x4 hv = *(const f32x4*)(hn + h * 128 + e0);
                u32x2 w; w.x = pk2(o[et][4 * g] * rn * hv.x, o[et][4 * g + 1] * rn * hv.y); w.y = pk2(o[et][4 * g + 2] * rn * hv.z, o[et][4 * g + 3] * rn * hv.w);
                *(u32x2*)(yo + e0) = w;
            }
    }
    __syncthreads();
}

__device__ __forceinline__ void phase_final(CArgs* a) {
    const int tid = fresh_tid(), lane = tid & 63, wave = tid >> 6;
    const bf16_t* xl = (const bf16_t*)(a->ws + WS_XF); const bf16_t* xh = (const bf16_t*)(a->ws + WS_XB);
    const float* ss = (const float*)(a->ws + WS_SS) + (size_t)12 * MTOK * 16; const float* gn = a->in[20];
    f32x4 g[4];
#pragma unroll
    for (int j = 0; j < 4; ++j) g[j] = ((const f32x4*)gn)[lane + 64 * j];
    for (int row0 = blockIdx.x * 8 + wave; row0 < MTOK; row0 += gridDim.x * 16) {
        const int row1 = row0 + gridDim.x * 8; const bool has1 = row1 < MTOK; const int r1 = has1 ? row1 : row0;
        const u32x2* hr0 = (const u32x2*)(xh + (size_t)row0 * DM) + lane; const u32x2* lr0 = (const u32x2*)(xl + (size_t)row0 * DM) + lane;
        const u32x2* hr1 = (const u32x2*)(xh + (size_t)r1 * DM) + lane; const u32x2* lr1 = (const u32x2*)(xl + (size_t)r1 * DM) + lane;
        u32x2 h0[4], h1[4];
#pragma unroll
        for (int j = 0; j < 4; ++j) { h0[j] = hr0[64 * j]; h1[j] = hr1[64 * j]; }
        const float ra = row_rs(ss, row0), rb = row_rs(ss, r1);
        f32x4* oo0 = (f32x4*)(a->out + (size_t)row0 * DM) + lane; f32x4* oo1 = (f32x4*)(a->out + (size_t)r1 * DM) + lane;
#pragma unroll
        for (int j = 0; j < 4; ++j) {
            const f32x4 x = {__uint_as_float(h0[j].x << 16), __uint_as_float(h0[j].x & 0xffff0000u), __uint_as_float(h0[j].y << 16), __uint_as_float(h0[j].y & 0xffff0000u)};
            oo0[64 * j] = x * ra * g[j];
        }
        if (has1) {
#pragma unroll
            for (int j = 0; j < 4; ++j) {
                const f32x4 x = {__uint_as_float(h1[j].x << 16), __uint_as_float(h1[j].x & 0xffff0000u), __uint_as_float(h1[j].y << 16), __uint_as_float(h1[j].y & 0xffff0000u)};
                oo1[64 * j] = x * rb * g[j];
            }
        }
    }
}

__device__ __forceinline__ void grid_bar(unsigned* ctr, unsigned target) {
    __syncthreads();
    if (fresh_tid() == 0) {
        __builtin_amdgcn_fence(__ATOMIC_RELEASE, "agent");
        __hip_atomic_fetch_add(ctr, 1u, __ATOMIC_RELAXED, __HIP_MEMORY_SCOPE_AGENT);
        while (__hip_atomic_load(ctr, __ATOMIC_RELAXED, __HIP_MEMORY_SCOPE_AGENT) < target) __builtin_amdgcn_s_sleep(2);
        __builtin_amdgcn_fence(__ATOMIC_ACQUIRE, "agent");
    }
    __syncthreads();
}
__device__ __forceinline__ void grid_bar2(unsigned* xarr, unsigned* top, unsigned nb, unsigned per) {
    asm volatile("s_waitcnt vmcnt(0)" ::: "memory");
    __syncthreads();
    if (fresh_tid() == 0) {
        const unsigned old = __hip_atomic_fetch_add(xarr, 1u, __ATOMIC_RELAXED, __HIP_MEMORY_SCOPE_AGENT);
        if (old + 1u == nb * per) { __builtin_amdgcn_fence(__ATOMIC_RELEASE, "agent"); __hip_atomic_fetch_add(top, 1u, __ATOMIC_RELAXED, __HIP_MEMORY_SCOPE_AGENT); }
        while (__hip_atomic_load(top, __ATOMIC_RELAXED, __HIP_MEMORY_SCOPE_AGENT) < nb * 8u) __builtin_amdgcn_s_sleep(2);
        __builtin_amdgcn_fence(__ATOMIC_ACQUIRE, "agent");
    }
    __syncthreads();
}
__device__ __forceinline__ unsigned xcc_id() { return (unsigned)__builtin_amdgcn_s_getreg((3 << 11) | 20) & 0xFu; }
__device__ __forceinline__ void xcd_bar(unsigned* ctr, unsigned target) {
    asm volatile("s_waitcnt vmcnt(0)" ::: "memory");
    __syncthreads();
    if (fresh_tid() == 0) {
        __hip_atomic_fetch_add(ctr, 1u, __ATOMIC_RELAXED, __HIP_MEMORY_SCOPE_AGENT);
        while (__hip_atomic_load(ctr, __ATOMIC_RELAXED, __HIP_MEMORY_SCOPE_AGENT) < target) __builtin_amdgcn_s_sleep(1);
        __builtin_amdgcn_fence(__ATOMIC_ACQUIRE, "agent");
    }
    __syncthreads();
}
__global__ void __launch_bounds__(512, 2) mega_fwd(Args a_val) {
    extern __shared__ __attribute__((aligned(16))) unsigned char lds_raw[];
    LAS unsigned char* lds = (LAS unsigned char*)lds_raw;
    const int ph_lo = a_val.ph_lo, ph_hi = a_val.ph_hi, coop = a_val.coop;
    unsigned nbar = 0, nxbar = 0, nbar2 = 0;
    LAS unsigned* blk = (LAS unsigned*)(lds + LDS_BYTES - 32);
    if (coop && ph_lo == 0) {
        if (fresh_tid() == 0) { const unsigned x = xcc_id() & 7u; blk[2] = x; blk[0] = __hip_atomic_fetch_add((unsigned*)(a_val.ws + WS_MISC + 640) + x, 1u, __ATOMIC_RELAXED, __HIP_MEMORY_SCOPE_AGENT) * 8u + x; blk[1] = 0u; }
    } else if (fresh_tid() == 0) { blk[0] = blockIdx.x; blk[1] = 0u; blk[2] = 0u; }
    __syncthreads();
    for (int ph = ph_lo; ph < ph_hi; ++ph) {
        CArgs* a = (CArgs*)__builtin_amdgcn_kernarg_segment_ptr();
        asm volatile("" : "+s"(a));
        unsigned char* ws = a->ws;
        float* xf = (float*)(ws + WS_XF); bf16_t* xb = (bf16_t*)(ws + WS_XB); float* ssb = (float*)(ws + WS_SS);
        bf16_t* act = (bf16_t*)(ws + WS_ACT); bf16_t* P = (bf16_t*)(ws + WS_P); bf16_t* ycat = (bf16_t*)(ws + WS_YCAT); bf16_t* GP = (bf16_t*)(ws + WS_GP);
        const unsigned char* tb = ws + WS_TAB;
        if (ph == 0) phase_p0(a, lds);
        else if (ph == NPHASE - 1) phase_final(a);
        else {
            const int l = (ph - 1) >> 3, k = (ph - 1) & 7;
            unsigned char* wb = wbuf(ws, l);
            for (int rep = 0; rep < (((PROBE_MASK >> k) & 1) ? 2 : 1); ++rep) {
            if (k == 0 || k == 6) {
                pg8::Gemm g{xb, (const bf16_t*)(wb + (k == 0 ? W_GU1 : W_GU2)), MTOK, 2 * DFF, DM}; pg8::StaticOrder S; S.init(MTOK, 2 * DFF, gridDim.x, (int)blk[0]);
                EpiSwiGLU E{act, ssb + (size_t)(3 * l + (k == 0 ? 0 : 2)) * MTOK * 16};
                pg8::gemm_phase<EpiSwiGLU, pg8::StaticOrder, true, true>(lds, g, S, E);
            } else if (k == 1 || k == 7 || k == 5) {
                const bf16_t* A = (k == 5) ? ycat : act; const int K = (k == 5) ? YW : DFF;
                const bf16_t* Bt = (const bf16_t*)(wb + (k == 1 ? W_D1 : (k == 7 ? W_D2 : W_O)));
                pg8::Gemm g{A, Bt, MTOK, DM, K}; pg8::StaticOrder S; S.init(MTOK, DM, gridDim.x, (int)blk[0]);
                EpiResid E{(l == 0 && k == 1) ? a->in[0] : (const float*)nullptr, (bf16_t*)xf, xb, ssb + (size_t)(3 * l + (k == 1 ? 1 : (k == 5 ? 2 : 3))) * MTOK * 16, (k == 5) ? 1.0f : 0.5f};
                pg8::gemm_phase<EpiResid, pg8::StaticOrder, true, true>(lds, g, S, E);
            } else if (k == 2) {
                pg8::Gemm g{xb, (const bf16_t*)(wb + W_IN), MTOK, 2048, DM}; pg8::StaticOrder S; S.init(MTOK, 2048, gridDim.x, (int)blk[0]);
                EpiWin E{P, (bf16_t*)(ws + WS_QC), ssb + (size_t)(3 * l + 1) * MTOK * 16};
                pg8::gemm_phase<EpiWin, pg8::StaticOrder, true, true>(lds, g, S, E);
            } else if (k == 3) {
                for (int u = blockIdx.x; u < 256; u += gridDim.x) fa_unit(lds, P, GP, tb, u >> 7, u & 127);
                for (int u = blockIdx.x; u < 256; u += gridDim.x) pool_unit(P, ycat, u);
                knorm_items((const bf16_t*)(ws + WS_KC), (float*)(ws + WS_MISC + 1024));
                fold_wout(a, l);
            } else {
                const float lam = ((const float*)(ws + WS_MISC))[l];
                const float outscale = 1.0f - (0.8f - 0.6f * expf(-0.3f * (float)l));
                unsigned* ctr = (unsigned*)(ws + WS_MISC + 256) + l;
                LAS int* uslot = (LAS int*)(lds + AT_MISC + 1024 + 64);
                const int nwork = 768 + ((l + 1 < NLAYER) ? CONV_CHUNKS : 0);
                for (;;) {
                    if (fresh_tid() == 0) *uslot = (int)atomicAdd(ctr, 1u);
                    __syncthreads();
                    const int u = *uslot;
                    __syncthreads();
                    if (u >= nwork) break;
                    if (u >= 512 && u < 768) { const int v = u - 512; fc_unit(lds, GP, ycat, tb, v >> 7, (v >> 1) & 63, v & 1); }
                    else if (u < 512) attn_unit(lds, (const bf16_t*)(ws + WS_QC), ycat, (const float*)(ws + WS_MISC + 1024), (u >> 6) & 1, 3 - (u >> 7), u & 63, lam, outscale, a->in[14] + l * 512);
                    else conv_chunk(a, l + 1, u - 768, lds);
                }
            }
            }
        }
        if (coop && ph + 1 < ph_hi) {
            if (coop == 2) cg::this_grid().sync();
            else {
                const int kk = (ph - 1) & 7;
                const bool local = blk[1] != 0u && ph >= 1 && ph < NPHASE - 2 && (kk == 0 || kk == 1 || kk >= 5);
                if (local) { ++nxbar; xcd_bar((unsigned*)(ws + WS_MISC + 704) + blk[2], nxbar * (gridDim.x >> 3)); }
                else if (blk[1] != 0u) { ++nbar2; grid_bar2((unsigned*)(ws + WS_MISC + 576) + blk[2], (unsigned*)(ws + WS_MISC + 516), nbar2, gridDim.x >> 3); }
                else { ++nbar; grid_bar((unsigned*)(ws + WS_MISC + 512), nbar * gridDim.x); }
                if (ph == 0) {
                    if (fresh_tid() == 0) {
                        bool even = (gridDim.x & 7u) == 0u;
                        for (int x = 0; x < 8; ++x) even = even && (__hip_atomic_load((unsigned*)(ws + WS_MISC + 640) + x, __ATOMIC_RELAXED, __HIP_MEMORY_SCOPE_AGENT) == (gridDim.x >> 3));
                        if (even) blk[1] = 1u; else blk[0] = blockIdx.x;
                    }
                    __syncthreads();
                }
            }
        }
    }
}

extern "C" void kernel_launch(void* const* d_in, const int* in_sizes, int n_in, void* d_out, int out_size, void* d_ws, size_t ws_size, hipStream_t stream) {
    static int grid = 0;
    if (grid == 0) {
        if (n_in != 21 || in_sizes[0] != MTOK * DM || out_size != MTOK * DM || ws_size < WS_END) {
            fprintf(stderr, "kernel_launch: unexpected problem (n_in %d, in0 %d, out %d, ws %zu); nothing launched\n", n_in, n_in > 0 ? in_sizes[0] : -1, out_size, ws_size); grid = -1; return; }
        int dev = 0, cus = 0, per_cu = 0;
        if (hipGetDevice(&dev) != hipSuccess || hipDeviceGetAttribute(&cus, hipDeviceAttributeMultiprocessorCount, dev) != hipSuccess) { fprintf(stderr, "kernel_launch: device query failed\n"); grid = -1; return; }
        if (hipFuncSetAttribute((const void*)mega_fwd, hipFuncAttributeMaxDynamicSharedMemorySize, LDS_BYTES) != hipSuccess) { fprintf(stderr, "kernel_launch: hipFuncSetAttribute failed\n"); grid = -1; return; }
        if (hipOccupancyMaxActiveBlocksPerMultiprocessor(&per_cu, (const void*)mega_fwd, 512, LDS_BYTES) != hipSuccess || per_cu < 1) { fprintf(stderr, "kernel_launch: occupancy query says %d blocks per CU\n", per_cu); per_cu = 1; }
        (void)hipGetLastError();
        grid = cus * per_cu;
    }
    if (grid < 0) return;
    Args a{};
    for (int i = 0; i < 21; ++i) a.in[i] = (const float*)d_in[i];
    a.out = (float*)d_out; a.ws = (unsigned char*)d_ws;
#if MK_MULTI
    for (int ph = 0; ph < NPHASE; ++ph) {
        a.ph_lo = ph; a.ph_hi = ph + 1; a.coop = 0;
        hipLaunchKernelGGL(mega_fwd, dim3(grid), dim3(512), LDS_BYTES, stream, a);
    }
#else
    a.ph_lo = 0; a.ph_hi = NPHASE; a.coop = 1;
    if (hipMemsetAsync((unsigned char*)d_ws + WS_MISC + 512, 0, 256, stream) != hipSuccess) { fprintf(stderr, "kernel_launch: hipMemsetAsync failed\n"); return; }
    void* args[] = {&a};
    hipError_t e = hipLaunchCooperativeKernel((const void*)mega_fwd, dim3(grid), dim3(512), args, LDS_BYTES, stream);
    if (e != hipSuccess) fprintf(stderr, "kernel_launch: cooperative launch failed: %s (grid %d)\n", hipGetErrorString(e), grid);
#endif
}
```

```cpp
#include <hip/hip_runtime.h>
#include <hip/hip_cooperative_groups.h>
#include <cstdio>
#include <cstdint>
namespace cg = cooperative_groups;
__device__ __forceinline__ int fresh_tid();
namespace pg8 {
#define PG8_LAS __attribute__((address_space(3)))
typedef unsigned short bf16_t;
typedef short bf16x8 __attribute__((ext_vector_type(8)));
typedef float f32x4 __attribute__((ext_vector_type(4)));
typedef unsigned u32x4 __attribute__((ext_vector_type(4)));
constexpr int BM = 256, BK = 64, HALF = 128, HTB = HALF * BK * 2  , STAGE_BYTES = 8 * HTB, NXCD = 8, WGM = 8;

__host__ __device__ __forceinline__ int lds_byte(int r, int c) { const int st = (r >> 4) * 2 + (c >> 5), rr = r & 15, cc = c & 31, ob = rr * 64 + cc * 2; return st * 1024 + (ob ^ (((ob >> 9) & 1) << 5)); }
__host__ __device__ __forceinline__ void stage_rc(int b, int& R, int& C) { const int st = b / 1024, sb = b % 1024, swz = sb ^ (((sb >> 9) & 1) << 5); R = (st >> 1) * 16 + swz / 64; C = (st & 1) * 32 + (swz % 64) / 2; }
__host__ __device__ __forceinline__ int perm32(int rho) { const int n = rho >> 4, i = rho & 15; return 8 * (i >> 2) + 4 * n + (i & 3); }

struct Unit { int pm, pn; };
struct Gemm { const bf16_t* A; const bf16_t* Bt; int M, N, K; };

struct StaticOrder {
    int nM, nN, nwg, G, c;
    __host__ __device__ void init(int M, int N, int G_, int c_) { nM = M / BM; nN = N / BM; nwg = nM * nN; G = G_; c = c_; }
    __host__ __device__ bool next(int i, Unit& u) const {
        const long L = (long)i * G + c; if (L >= nwg) return false;
        int wgid = (int)L; { const int q = nwg / NXCD, r = nwg % NXCD, xcd = wgid % NXCD, off = wgid / NXCD; wgid = (xcd < r ? xcd * (q + 1) : r * (q + 1) + (xcd - r) * q) + off; }
        const int nig = WGM * nN, gid = wgid / nig, fm = gid * WGM, gsz = (nM - fm) < WGM ? (nM - fm) : WGM;
        u.pm = fm + ((wgid % nig) % gsz); u.pn = (wgid % nig) / gsz; return true;
    }
    __device__ __forceinline__ void a_ready(const Unit&) const {}
    __device__ __forceinline__ void done(const Unit&) const {}
};
__device__ __forceinline__ unsigned cvt_pk_bf16(float lo, float hi) { unsigned r; asm volatile("v_cvt_pk_bf16_f32 %0, %1, %2" : "=v"(r) : "v"(lo), "v"(hi)); return r; }
template <class Epi, class Sched, bool ALIGN_EPI = false, bool SP2 = false>
__device__ __forceinline__ void gemm_phase(PG8_LAS unsigned char* lds, const Gemm g, const Sched& S, const Epi& E) {
    const int tid = fresh_tid(), wid = __builtin_amdgcn_readfirstlane(tid >> 6), lane = tid & 63, wr = wid >> 2, wc = wid & 3, fr = lane & 15, fq = lane >> 4;
    const int K = g.K, nt = K / BK;
    unsigned voffA[2], voffB[2];
#pragma unroll
    for (int i = 0; i < 2; ++i) { int R, C; stage_rc(tid * 16 + i * 8192, R, C); const int Rb = Epi::PERM ? ((R & ~31) + perm32(R & 31)) : R;
        voffA[i] = (unsigned)(R * K + C) * 2u; voffB[i] = (unsigned)(Rb * K + C) * 2u; }
    const size_t kstep = (size_t)(BK * 2);
    const size_t hstep = (size_t)HALF * K * 2;
    const size_t tstep = 2 * hstep;
    const unsigned ldsw = (unsigned)wid * 1024u;
    const int aoff = lds_byte(wr * 64 + fr, fq * 8), boff = lds_byte(wc * 32 + fr, fq * 8);
#define PG8_SA(b, h) (((b) * 2 + (h)) * HTB)
#define PG8_SB(b, h) ((4 + (b) * 2 + (h)) * HTB)
#define PG8_STAGE(bufoff, gbase, voff) do { _Pragma("unroll") for (int _i = 0; _i < 2; ++_i) \
        __builtin_amdgcn_global_load_lds((const unsigned*)((const char*)(gbase) + (voff)[_i]), (PG8_LAS unsigned*)(lds + (bufoff) + ldsw + _i * 8192), 16, 0, 0); } while (0)
#define PG8_LDA(dst, b, h) do { _Pragma("unroll") for (int m = 0; m < 4; ++m) _Pragma("unroll") for (int k = 0; k < 2; ++k) dst[m][k] = *(const PG8_LAS bf16x8*)(lds + PG8_SA(b, h) + aoff + m * 2048 + k * 1024); } while (0)
#define PG8_LDB(dst, b, h) do { _Pragma("unroll") for (int n = 0; n < 2; ++n) _Pragma("unroll") for (int k = 0; k < 2; ++k) dst[n][k] = *(const PG8_LAS bf16x8*)(lds + PG8_SB(b, h) + boff + n * 2048 + k * 1024); } while (0)
#define PG8_MMA(ai, bj, At, Bt) do { __builtin_amdgcn_s_setprio(1); _Pragma("unroll") for (int m = 0; m < 4; ++m) _Pragma("unroll") for (int n = 0; n < 2; ++n) _Pragma("unroll") for (int k = 0; k < 2; ++k) \
        acc[ai][bj][m][n] = __builtin_amdgcn_mfma_f32_16x16x32_bf16(Bt[n][k], At[m][k], acc[ai][bj][m][n], 0, 0, 0); __builtin_amdgcn_s_setprio(0); } while (0)
#define PG8_WAIT_V(n) asm volatile("s_waitcnt vmcnt(" #n ")" ::: "memory")
#define PG8_WAIT_L(n) asm volatile("s_waitcnt lgkmcnt(" #n ")" ::: "memory")
#define PG8_BAR __builtin_amdgcn_s_barrier()
#define PG8_SCHED __builtin_amdgcn_sched_barrier(0)
    Unit cur, nxt; int ui = 0;
    if (!S.next(0, cur)) return;
    f32x4 acc[2][2][4][2];
#pragma unroll
    for (int a = 0; a < 2; ++a)
#pragma unroll
        for (int b = 0; b < 2; ++b)
#pragma unroll
            for (int m = 0; m < 4; ++m)
#pragma unroll
                for (int n = 0; n < 2; ++n) acc[a][b][m][n] = (f32x4){0.f, 0.f, 0.f, 0.f};
    bf16x8 At[4][2], B0[2][2], B1[2][2];
    const char* cA = (const char*)g.A + (size_t)cur.pm * tstep; const char* cB = (const char*)g.Bt + (size_t)cur.pn * tstep;
    S.a_ready(cur);
    if constexpr (SP2) {
        PG8_STAGE(PG8_SB(0, 0), cB, voffB); PG8_STAGE(PG8_SB(0, 1), cB + hstep, voffB); PG8_STAGE(PG8_SA(0, 0), cA, voffA); PG8_STAGE(PG8_SA(0, 1), cA + hstep, voffA);
        if (wr == 1) PG8_BAR;
        PG8_WAIT_V(2); PG8_BAR;
        PG8_STAGE(PG8_SB(1, 0), cB + kstep, voffB); PG8_STAGE(PG8_SA(1, 0), cA + kstep, voffA); PG8_STAGE(PG8_SB(1, 1), cB + hstep + kstep, voffB);
        PG8_WAIT_V(6); PG8_BAR;
    } else {
        PG8_STAGE(PG8_SB(0, 0), cB, voffB); PG8_STAGE(PG8_SA(0, 0), cA, voffA); PG8_STAGE(PG8_SB(0, 1), cB + hstep, voffB); PG8_STAGE(PG8_SA(0, 1), cA + hstep, voffA);
        if (wr == 1) PG8_BAR;
        PG8_WAIT_V(4); PG8_BAR;
        PG8_STAGE(PG8_SB(1, 0), cB + kstep, voffB); PG8_STAGE(PG8_SA(1, 0), cA + kstep, voffA); PG8_STAGE(PG8_SB(1, 1), cB + hstep + kstep, voffB);
        PG8_WAIT_V(6); PG8_BAR;
    }
    for (;;) {
        const bool has_next = S.next(ui + 1, nxt);
        const char* nA = has_next ? (const char*)g.A + (size_t)nxt.pm * tstep : cA; const char* nB = has_next ? (const char*)g.Bt + (size_t)nxt.pn * tstep : cB;
        for (int t = 0; t < nt; t += 2) {
            const bool last = (t == nt - 2);
            const char* a1 = cA + (size_t)(t + 1) * kstep;
            const char* a2 = last ? nA : cA + (size_t)(t + 2) * kstep; const char* b2 = last ? nB : cB + (size_t)(t + 2) * kstep;
            const char* a3 = a2 + kstep; const char* b3 = b2 + kstep;
            if (last && has_next) S.a_ready(nxt);
            if constexpr (SP2) {
            PG8_LDB(B0, 0, 0); PG8_LDB(B1, 0, 1); PG8_SCHED; PG8_LDA(At, 0, 0); PG8_STAGE(PG8_SA(1, 1), a1 + hstep, voffA);
            PG8_WAIT_V(8); PG8_WAIT_L(0); PG8_BAR; PG8_MMA(0, 0, At, B0); PG8_MMA(0, 1, At, B1); PG8_BAR; PG8_SCHED;
            PG8_LDA(At, 0, 1); PG8_STAGE(PG8_SB(0, 0), b2, voffB); PG8_STAGE(PG8_SB(0, 1), b2 + hstep, voffB); PG8_STAGE(PG8_SA(0, 0), a2, voffA);
            PG8_WAIT_V(8); PG8_WAIT_L(0); PG8_BAR; PG8_MMA(1, 0, At, B0); PG8_MMA(1, 1, At, B1); PG8_BAR; PG8_SCHED;
            PG8_LDB(B0, 1, 0); PG8_LDB(B1, 1, 1); PG8_SCHED; PG8_LDA(At, 1, 0); PG8_STAGE(PG8_SA(0, 1), a2 + hstep, voffA);
            PG8_WAIT_V(8); PG8_WAIT_L(0); PG8_BAR; PG8_MMA(0, 0, At, B0); PG8_MMA(0, 1, At, B1); PG8_BAR; PG8_SCHED;
            PG8_LDA(At, 1, 1); PG8_STAGE(PG8_SB(1, 0), b3, voffB); PG8_STAGE(PG8_SB(1, 1), b3 + hstep, voffB); PG8_STAGE(PG8_SA(1, 0), a3, voffA);
            PG8_WAIT_V(8); PG8_WAIT_L(0); PG8_BAR; PG8_MMA(1, 0, At, B0); PG8_MMA(1, 1, At, B1); PG8_BAR; PG8_SCHED;
            } else {
            PG8_LDB(B0, 0, 0); PG8_SCHED; PG8_LDA(At, 0, 0); PG8_STAGE(PG8_SA(1, 1), a1 + hstep, voffA);
            PG8_WAIT_L(8); PG8_BAR; PG8_WAIT_L(0); PG8_MMA(0, 0, At, B0); PG8_BAR; PG8_SCHED;
            PG8_LDB(B1, 0, 1); PG8_STAGE(PG8_SB(0, 0), b2, voffB);
            PG8_BAR; PG8_WAIT_L(0); PG8_MMA(0, 1, At, B1); PG8_BAR;
            PG8_LDA(At, 0, 1); PG8_STAGE(PG8_SA(0, 0), a2, voffA);
            PG8_BAR; PG8_WAIT_L(0); PG8_MMA(1, 0, At, B0); PG8_BAR; PG8_SCHED;
            PG8_STAGE(PG8_SB(0, 1), b2 + hstep, voffB);
            PG8_WAIT_V(6); PG8_BAR; PG8_MMA(1, 1, At, B1); PG8_BAR;
            PG8_LDB(B0, 1, 0); PG8_SCHED; PG8_LDA(At, 1, 0); PG8_STAGE(PG8_SA(0, 1), a2 + hstep, voffA);
            PG8_WAIT_L(8); PG8_BAR; PG8_WAIT_L(0); PG8_MMA(0, 0, At, B0); PG8_BAR; PG8_SCHED;
            PG8_LDB(B1, 1, 1); PG8_STAGE(PG8_SB(1, 0), b3, voffB);
            PG8_BAR; PG8_WAIT_L(0); PG8_MMA(0, 1, At, B1); PG8_BAR;
            PG8_LDA(At, 1, 1); PG8_STAGE(PG8_SA(1, 0), a3, voffA);
            PG8_BAR; PG8_WAIT_L(0); PG8_MMA(1, 0, At, B0); PG8_BAR; PG8_SCHED;
            PG8_STAGE(PG8_SB(1, 1), b3 + hstep, voffB);
            PG8_WAIT_V(6); PG8_BAR; PG8_MMA(1, 1, At, B1); PG8_BAR;
            }
        }
        if constexpr (ALIGN_EPI) { if (wr == 0) PG8_BAR; }
        if constexpr (!Epi::AFTER_DRAIN) { E(acc, cur, wr, wc, fr, fq); S.done(cur); }
        if (!has_next) break;
#pragma unroll
        for (int a = 0; a < 2; ++a)
#pragma unroll
            for (int b = 0; b < 2; ++b)
#pragma unroll
                for (int m = 0; m < 4; ++m)
#pragma unroll
                    for (int n = 0; n < 2; ++n) acc[a][b][m][n] = (f32x4){0.f, 0.f, 0.f, 0.f};
        cur = nxt; cA = nA; cB = nB; ++ui;
        if constexpr (ALIGN_EPI) { if (wr == 1) PG8_BAR; }
    }
    PG8_WAIT_V(0);
    if constexpr (!ALIGN_EPI) { if (wr == 0) PG8_BAR; }
    PG8_BAR;
    if constexpr (Epi::AFTER_DRAIN) { E.fused(acc, cur, wr, wc, fr, fq, lds, wid, lane); S.done(cur); }
#undef PG8_SA
#undef PG8_SB
#undef PG8_STAGE
#undef PG8_LDA
#undef PG8_LDB
#undef PG8_MMA
#undef PG8_WAIT_V
#undef PG8_WAIT_L
#undef PG8_BAR
#undef PG8_SCHED
}
}

#define LAS __attribute__((address_space(3)))
typedef unsigned short bf16_t;
typedef short bf16x8 __attribute__((ext_vector_type(8)));
typedef short s16x4 __attribute__((ext_vector_type(4)));
typedef short v4i16_t __attribute__((ext_vector_type(4)));
typedef float f32x2 __attribute__((ext_vector_type(2)));
typedef float f32x4 __attribute__((ext_vector_type(4)));
typedef float f32x16 __attribute__((ext_vector_type(16)));
typedef unsigned u32x2 __attribute__((ext_vector_type(2)));
typedef unsigned u32x4 __attribute__((ext_vector_type(4)));
typedef __bf16 bf16x2_t __attribute__((ext_vector_type(2)));

#ifndef PROBE_MASK
#define PROBE_MASK 0
#endif
#ifndef MK_MULTI
#define MK_MULTI 0
#endif

constexpr int MTOK = 16384, DM = 1024, DFF = 2816, SEQ = 8192, NLAYER = 4;
constexpr int PW = 512;
constexpr int YW = 1280;
constexpr float EPS = 1e-6f;
constexpr float LOG2E = 1.4426950408889634f;
constexpr float QSCALE = 0.125f * LOG2E;
constexpr size_t MiB = (size_t)1 << 20;
constexpr size_t WS_MISC = 0, WS_TAB = 2 * MiB, WS_WFWO = 3 * MiB, WS_W = 4 * MiB;
constexpr size_t WS_XF = 48 * MiB, WS_XB = 112 * MiB, WS_ACT = 144 * MiB, WS_P = 144 * MiB, WS_YCAT = 208 * MiB, WS_GP = 248 * MiB, WS_SS = 264 * MiB, WS_QC = 160 * MiB, WS_KC = 176 * MiB, WS_VC = 192 * MiB, WS_W1 = 277 * MiB, WS_END = 317 * MiB;
constexpr size_t W_GU1 = 0, W_D1 = 11534336, W_GU2 = 17301504, W_D2 = 28835840, W_IN = 34603008, W_O = 38797312;
constexpr size_t TB_64C = 0, TB_64S = 8192, TB_128C = 16384, TB_128S = 49152, TB_TWC = 81920, TB_TWS = 114688, TB_64FC = 147456, TB_64FS = 163840;
constexpr int LDS_BYTES = 139264;
constexpr int NPHASE = 1 + 8 * NLAYER + 1;
constexpr int CONV_TILE_CHUNKS = 1216, CONV_CHUNKS = CONV_TILE_CHUNKS + 128;

struct Args { const float* in[21]; float* out; unsigned char* ws; int ph_lo, ph_hi, coop, pad; };
typedef const __attribute__((address_space(4))) Args CArgs;

__device__ __forceinline__ unsigned pk2(float lo, float hi) { f32x2 v = {lo, hi}; bf16x2_t b = __builtin_convertvector(v, bf16x2_t); return __builtin_bit_cast(unsigned, b); }
__device__ __forceinline__ bf16_t bf1(float x) { return (bf16_t)(pk2(x, 0.f) & 0xffffu); }
__device__ __forceinline__ float wave_sum(float v) {
#pragma unroll
    for (int o = 1; o < 64; o <<= 1) v += __shfl_xor(v, o);
    return v;
}
__device__ __forceinline__ int fresh_tid() { int t; asm volatile("v_mov_b32 %0, %1" : "=v"(t) : "v"((int)threadIdx.x)); return t; }
__device__ __forceinline__ unsigned char* wbuf(unsigned char* ws, int l) { return ws + ((l & 1) ? WS_W1 : WS_W); }
__device__ __forceinline__ int crow(int r, int hi) { return (r & 3) + 8 * (r >> 2) + 4 * hi; }
__device__ __forceinline__ s16x4 vtr(const LAS unsigned char* p) { return __builtin_bit_cast(s16x4, __builtin_amdgcn_ds_read_tr16_b64_v4i16((LAS v4i16_t*)p)); }
__device__ __forceinline__ bf16x8 cat8(s16x4 lo, s16x4 hi) { return __builtin_shufflevector(lo, hi, 0, 1, 2, 3, 4, 5, 6, 7); }
#define MFMA32(a, b, c) __builtin_amdgcn_mfma_f32_32x32x16_bf16((a), (b), (c), 0, 0, 0)

__device__ __forceinline__ float row_rs(const float* ss, int row) {
    const f32x4* p = (const f32x4*)(ss + (size_t)row * 16); const f32x4 a = p[0], b = p[1], c = p[2], d = p[3];
    const float s = (((a.x + a.y) + (a.z + a.w)) + ((b.x + b.y) + (b.z + b.w))) + (((c.x + c.y) + (c.z + c.w)) + ((d.x + d.y) + (d.z + d.w)));
    return rsqrtf(s * (1.0f / DM) + EPS);
}
__device__ __forceinline__ void rows_rs8(const float* ss, int row0, int fq, float (&r)[8]) {
    f32x4 pv[8];
#pragma unroll
    for (int i = 0; i < 8; ++i) pv[i] = ((const f32x4*)(ss + (size_t)(row0 + (i >> 2) * 128 + (i & 3) * 16) * 16))[fq];
#pragma unroll
    for (int i = 0; i < 8; ++i) {
        float q = (pv[i].x + pv[i].y) + (pv[i].z + pv[i].w);
        q += __shfl_xor(q, 16); q += __shfl_xor(q, 32);
        r[i] = rsqrtf(q * (1.0f / DM) + EPS);
    }
}
struct EpiSwiGLU {
    static constexpr bool PERM = true, AFTER_DRAIN = false;
    bf16_t* act; const float* ss;
    __device__ __forceinline__ void operator()(const pg8::f32x4 (&acc)[2][2][4][2], const pg8::Unit& u, int wr, int wc, int fr, int fq) const {
        const int row0 = u.pm * 256 + wr * 64 + fr, col0 = u.pn * 128 + wc * 32 + 8 * fq;
        float rs[8]; rows_rs8(ss, row0, fq, rs);
#pragma unroll
        for (int ai = 0; ai < 2; ++ai)
#pragma unroll
            for (int m = 0; m < 4; ++m) {
                const int row = row0 + ai * 128 + m * 16;
                const float r = rs[ai * 4 + m];
                float o[8];
#pragma unroll
                for (int n = 0; n < 2; ++n)
#pragma unroll
                    for (int i = 0; i < 4; ++i) {
                        const float g = acc[ai][0][m][n][i] * r, up = acc[ai][1][m][n][i] * r;
                        const float sg = g * __builtin_amdgcn_rcpf(1.0f + __builtin_amdgcn_exp2f(-g * LOG2E));
                        o[4 * n + i] = sg * up;
                    }
                u32x4 w; w.x = pk2(o[0], o[1]); w.y = pk2(o[2], o[3]); w.z = pk2(o[4], o[5]); w.w = pk2(o[6], o[7]);
                *(u32x4*)(act + (size_t)row * DFF + col0) = w;
            }
    }
};
struct EpiResid {
    static constexpr bool PERM = true, AFTER_DRAIN = false;
    const float* xin; bf16_t* xl; bf16_t* xb; float* ss_out; float scale;
    __device__ __forceinline__ void operator()(const pg8::f32x4 (&acc)[2][2][4][2], const pg8::Unit& u, int wr, int wc, int fr, int fq) const {
        const int row0 = u.pm * 256 + wr * 64 + fr, col0 = u.pn * 256 + wc * 32 + 8 * fq;
#pragma unroll
        for (int ai = 0; ai < 2; ++ai)
#pragma unroll
            for (int m = 0; m < 4; ++m) {
                const int row = row0 + ai * 128 + m * 16;
                float sq = 0.f;
#pragma unroll
                for (int bj = 0; bj < 2; ++bj) {
                    const size_t off = (size_t)row * DM + col0 + bj * 128;
                    f32x4 x0, x1;
                    if (xin) { x0 = *(const f32x4*)(xin + off); x1 = *(const f32x4*)(xin + off + 4); }
                    else {
                        const u32x4 h = *(const u32x4*)(xb + off);
                        x0 = (f32x4){__uint_as_float(h.x << 16), __uint_as_float(h.x & 0xffff0000u), __uint_as_float(h.y << 16), __uint_as_float(h.y & 0xffff0000u)};
                        x1 = (f32x4){__uint_as_float(h.z << 16), __uint_as_float(h.z & 0xffff0000u), __uint_as_float(h.w << 16), __uint_as_float(h.w & 0xffff0000u)};
                    }
                    x0 = x0 + acc[ai][bj][m][0] * scale; x1 = x1 + acc[ai][bj][m][1] * scale;
                    sq += (x0.x * x0.x + x0.y * x0.y) + (x0.z * x0.z + x0.w * x0.w) + (x1.x * x1.x + x1.y * x1.y) + (x1.z * x1.z + x1.w * x1.w);
                    u32x4 w; w.x = pk2(x0.x, x0.y); w.y = pk2(x0.z, x0.w); w.z = pk2(x1.x, x1.y); w.w = pk2(x1.z, x1.w);
                    *(u32x4*)(xb + off) = w;
                }
                sq += __shfl_xor(sq, 16); sq += __shfl_xor(sq, 32);
                if (fq == 0) ss_out[(size_t)row * 16 + u.pn * 4 + wc] = sq;
            }
    }
};
struct EpiWin {
    static constexpr bool PERM = true, AFTER_DRAIN = false;
    bf16_t* P; bf16_t* QKV; const float* ss;
    __device__ __forceinline__ void operator()(const pg8::f32x4 (&acc)[2][2][4][2], const pg8::Unit& u, int wr, int wc, int fr, int fq) const {
        const int row0 = u.pm * 256 + wr * 64 + fr, cw = wc * 32 + 8 * fq;
        const float qs = (u.pn == 2 || u.pn == 3) ? QSCALE : 1.0f;
        float rs[8]; rows_rs8(ss, row0, fq, rs);
#pragma unroll
        for (int ai = 0; ai < 2; ++ai)
#pragma unroll
            for (int m = 0; m < 4; ++m) {
                const int row = row0 + ai * 128 + m * 16;
                const float r = rs[ai * 4 + m] * qs;
#pragma unroll
                for (int bj = 0; bj < 2; ++bj) {
                    const f32x4 v0 = acc[ai][bj][m][0] * r, v1 = acc[ai][bj][m][1] * r;
                    u32x4 w; w.x = pk2(v0.x, v0.y); w.y = pk2(v0.z, v0.w); w.z = pk2(v1.x, v1.y); w.w = pk2(v1.z, v1.w);
                    if (u.pn < 2) *(u32x4*)(P + (size_t)row * PW + u.pn * 256 + bj * 128 + cw) = w;
                    else { const int sect = (u.pn - 2) >> 1, h = ((u.pn & 1) << 1) + bj;
                        *(u32x4*)(QKV + (size_t)sect * (8u << 20) + ((size_t)(((row >> 13) * 4 + h) * SEQ + (row & (SEQ - 1)))) * 128 + cw) = w; }
                }
            }
    }
};

__device__ __forceinline__ void conv_chunk(CArgs* a, int l, int chunk, LAS unsigned char* lds);
__device__ __forceinline__ void phase_p0(CArgs* a, LAS unsigned char* lds) {
    const int tid = fresh_tid(), lane = tid & 63, wave = tid >> 6;
    unsigned char* ws = a->ws;
    float* xf = (float*)(ws + WS_XF); bf16_t* xb = (bf16_t*)(ws + WS_XB); float* ss = (float*)(ws + WS_SS);
    const float* x = a->in[0];
    for (int row0 = blockIdx.x * 8 + wave; row0 < MTOK; row0 += gridDim.x * 16) {
        const int row1 = row0 + gridDim.x * 8; const bool has1 = row1 < MTOK; const int r1 = has1 ? row1 : row0;
        const f32x4* xr0 = (const f32x4*)(x + (size_t)row0 * DM) + lane; const f32x4* xr1 = (const f32x4*)(x + (size_t)r1 * DM) + lane;
        f32x4 v0[4], v1[4]; float s0 = 0.f, s1 = 0.f;
#pragma unroll
        for (int j = 0; j < 4; ++j) { v0[j] = __builtin_nontemporal_load(xr0 + 64 * j); v1[j] = __builtin_nontemporal_load(xr1 + 64 * j); }
#pragma unroll
        for (int j = 0; j < 4; ++j) { s0 += (v0[j].x * v0[j].x + v0[j].y * v0[j].y) + (v0[j].z * v0[j].z + v0[j].w * v0[j].w); s1 += (v1[j].x * v1[j].x + v1[j].y * v1[j].y) + (v1[j].z * v1[j].z + v1[j].w * v1[j].w); }
        s0 = wave_sum(s0); s1 = wave_sum(s1);
        u32x2* bo0 = (u32x2*)(xb + (size_t)row0 * DM) + lane; u32x2* bo1 = (u32x2*)(xb + (size_t)r1 * DM) + lane;
#pragma unroll
        for (int j = 0; j < 4; ++j) { u32x2 w; w.x = pk2(v0[j].x, v0[j].y); w.y = pk2(v0[j].z, v0[j].w); bo0[64 * j] = w; }
        if (lane < 16) ss[(size_t)row0 * 16 + lane] = (lane == 0) ? s0 : 0.f;
        if (has1) {
#pragma unroll
            for (int j = 0; j < 4; ++j) { u32x2 w; w.x = pk2(v1[j].x, v1[j].y); w.y = pk2(v1[j].z, v1[j].w); bo1[64 * j] = w; }
            if (lane < 16) ss[(size_t)row1 * 16 + lane] = (lane == 0) ? s1 : 0.f;
        }
    }
    const int gtid = blockIdx.x * 512 + tid, NT = gridDim.x * 512;
    unsigned char* tb = ws + WS_TAB;
    for (int i = gtid; i < 4096; i += NT) {
        const int k = i >> 6, s = i & 63, idx = (k * s) & 63;
        const float c = cospif((float)idx * (2.0f / 64.0f)), sn = sinpif((float)idx * (2.0f / 64.0f));
        ((bf16_t*)(tb + TB_64C))[i] = bf1(c); ((bf16_t*)(tb + TB_64S))[i] = bf1(sn);
        ((float*)(tb + TB_64FC))[i] = c; ((float*)(tb + TB_64FS))[i] = sn;
    }
    for (int i = gtid; i < 16384; i += NT) {
        const int k = i >> 7, s = i & 127, idx = (k * s) & 127;
        ((bf16_t*)(tb + TB_128C))[i] = bf1(cospif((float)idx * (2.0f / 128.0f))); ((bf16_t*)(tb + TB_128S))[i] = bf1(sinpif((float)idx * (2.0f / 128.0f)));
    }
    for (int i = gtid; i < 8192; i += NT) {
        const int s2 = i >> 6, k1 = i & 63, idx = s2 * k1;
        ((float*)(tb + TB_TWC))[i] = cospif((float)idx * (2.0f / 8192.0f)); ((float*)(tb + TB_TWS))[i] = sinpif((float)idx * (2.0f / 8192.0f));
    }
    for (int chunk = blockIdx.x; chunk < CONV_CHUNKS; chunk += gridDim.x) conv_chunk(a, 0, chunk, lds);
    if (blockIdx.x == 0 && tid < 8) ((unsigned*)(ws + WS_MISC + 256))[tid] = 0u;
    if (blockIdx.x == 0 && wave == 0) {
        for (int l = 0; l < NLAYER; ++l) {
            const float p1 = a->in[10][l * 64 + lane] * a->in[11][l * 64 + lane], p2 = a->in[12][l * 64 + lane] * a->in[13][l * 64 + lane];
            const float s1 = wave_sum(p1), s2 = wave_sum(p2);
            if (lane == 0) ((float*)(ws + WS_MISC))[l] = expf(s1) - expf(s2) + (0.8f - 0.6f * expf(-0.3f * (float)l));
        }
    }
}

__device__ __forceinline__ void conv_wtile(const float* src, int ld_src, int k0, int n0, const float* gain, bf16_t* dst, int ld_dst, int kofs, int nmode, LAS float* scr, int lane) {
    float v[32];
    const float* sp0 = src + (size_t)(k0 + (lane >> 5)) * ld_src + n0 + (lane & 31);
#pragma unroll
    for (int i = 0; i < 32; ++i) v[i] = __builtin_nontemporal_load(sp0 + (size_t)(2 * i) * ld_src);
#pragma unroll
    for (int i = 0; i < 32; ++i) scr[(2 * i + (lane >> 5)) * 33 + (lane & 31)] = v[i];
    asm volatile("s_waitcnt lgkmcnt(0)" ::: "memory");
    const int c = lane & 7;
    f32x4 g0 = {1.f, 1.f, 1.f, 1.f}, g1 = {1.f, 1.f, 1.f, 1.f};
    if (gain) { g0 = *(const f32x4*)(gain + k0 + 8 * c); g1 = *(const f32x4*)(gain + k0 + 8 * c + 4); }
#pragma unroll
    for (int j = 0; j < 4; ++j) {
        const int nl = (lane >> 3) + 8 * j, n = n0 + nl;
        const int np = (nmode == 0) ? n : (256 * (n >> 7) + (n & 127) + (nmode == 2 ? 128 : 0));
        const LAS float* sp = scr + (8 * c) * 33 + nl;
        u32x4 o; o.x = pk2(sp[0] * g0.x, sp[33] * g0.y); o.y = pk2(sp[2 * 33] * g0.z, sp[3 * 33] * g0.w); o.z = pk2(sp[4 * 33] * g1.x, sp[5 * 33] * g1.y); o.w = pk2(sp[6 * 33] * g1.z, sp[7 * 33] * g1.w);
        *(u32x4*)(dst + (size_t)np * ld_dst + kofs + k0 + 8 * c) = o;
    }
    asm volatile("s_waitcnt lgkmcnt(0)" ::: "memory");
}
__device__ __forceinline__ void conv_chunk(CArgs* a, int l, int chunk, LAS unsigned char* lds) {
    const int tid = fresh_tid(), lane = tid & 63, wave = tid >> 6;
    if (chunk < CONV_TILE_CHUNKS) {
        LAS float* scr = (LAS float*)(lds + wave * 8448);
        unsigned char* wb = wbuf(a->ws, l);
        const size_t FW = (size_t)DM * DFF;
        const int it = chunk * 8 + wave;
        if (it < 8448) {
            const int f = it / 4224, r = it % 4224;
            const float* gn = a->in[f ? 16 : 1] + l * DM;
            if (r < 2816) {
                const int up = r / 1408, t = r % 1408, kt = t / 88, nt = t % 88;
                const float* src = a->in[f ? (up ? 18 : 17) : (up ? 3 : 2)] + (size_t)l * FW;
                conv_wtile(src, DFF, kt * 64, nt * 32, gn, (bf16_t*)(wb + (f ? W_GU2 : W_GU1)), DM, 0, up ? 2 : 1, scr, lane);
            } else {
                const int t = r - 2816, kt = t / 32, nt = t % 32;
                const float* src = a->in[f ? 19 : 4] + (size_t)l * FW;
                conv_wtile(src, DM, kt * 64, nt * 32, nullptr, (bf16_t*)(wb + (f ? W_D2 : W_D1)), DFF, 0, 0, scr, lane);
            }
        } else if (it < 9472) {
            const int t = it - 8448, kt = t / 64, nt = t % 64;
            conv_wtile(a->in[6] + (size_t)l * DM * 2048, 2048, kt * 64, nt * 32, a->in[5] + l * DM, (bf16_t*)(wb + W_IN), DM, 0, 0, scr, lane);
        } else {
            const int t = it - 9472, kt = t / 32, nt = t % 32;
            conv_wtile(a->in[15] + (size_t)l * DM * DM + (size_t)512 * DM, DM, kt * 64, nt * 32, nullptr, (bf16_t*)(wb + W_O), YW, 768, 0, scr, lane);
        }
    } else {
        const float* fw = a->in[9] + (size_t)l * 256 * 256; const float* wo = a->in[15] + (size_t)l * DM * DM + (size_t)256 * DM;
        float* wfwo = (float*)(a->ws + WS_WFWO);
        const int item = __builtin_amdgcn_readfirstlane((chunk - CONV_TILE_CHUNKS) * 8 + wave), rb = item >> 8, n0 = (item & 255) * 4, r = rb * 64 + lane;
        float acc0 = 0.f, acc1 = 0.f, acc2 = 0.f, acc3 = 0.f;
#pragma unroll 1
        for (int cc = 0; cc < 4; ++cc) {
            f32x4 av[16];
#pragma unroll
            for (int i = 0; i < 16; ++i) av[i] = *(const f32x4*)(fw + (size_t)r * 256 + cc * 64 + 4 * i);
            const float* B = wo + (size_t)(cc * 64) * DM + n0;
#pragma unroll
            for (int i = 0; i < 16; ++i)
#pragma unroll
                for (int e = 0; e < 4; ++e) {
                    const f32x4 bv = *(const f32x4*)(B + (size_t)(4 * i + e) * DM);
                    acc0 = fmaf(av[i][e], bv.x, acc0); acc1 = fmaf(av[i][e], bv.y, acc1); acc2 = fmaf(av[i][e], bv.z, acc2); acc3 = fmaf(av[i][e], bv.w, acc3);
                }
        }
        *(f32x4*)(wfwo + (size_t)r * DM + n0) = (f32x4){acc0, acc1, acc2, acc3};
    }
}
__device__ __forceinline__ void fold_wout(CArgs* a, int l) {
    const int tid = fresh_tid(), lane = tid & 63, wave = tid >> 6;
    const float* pw = a->in[7] + (size_t)l * 4 * 64 * 64; const float* ps = a->in[8] + l * 256; const float* wo = a->in[15] + (size_t)l * DM * DM;
    const float* wfwo = (const float*)(a->ws + WS_WFWO);
    const float* fc = (const float*)(a->ws + WS_TAB + TB_64FC); const float* fs = (const float*)(a->ws + WS_TAB + TB_64FS);
    bf16_t* wot = (bf16_t*)(wbuf(a->ws, l) + W_O);
    for (int item = __builtin_amdgcn_readfirstlane(blockIdx.x * 8 + wave); item < 3072; item += gridDim.x * 8) {
        const int sec = item >> 10, g = (item >> 8) & 3, n0 = (item & 255) * 4;
        const float* arow = (sec == 0) ? pw + (g * 64 + lane) * 64 : ((sec == 1) ? fc + lane * 64 : fs + lane * 64);
        const float* B = ((sec == 0) ? wo : wfwo) + (size_t)(g * 64) * DM + n0;
        float acc0 = 0.f, acc1 = 0.f, acc2 = 0.f, acc3 = 0.f;
#pragma unroll 4
        for (int d4 = 0; d4 < 16; ++d4) {
            f32x4 av = *(const f32x4*)(arow + 4 * d4);
            if (sec == 0) av = av * *(const f32x4*)(ps + g * 64 + 4 * d4);
#pragma unroll
            for (int e = 0; e < 4; ++e) {
                const f32x4 bv = *(const f32x4*)(B + (size_t)(4 * d4 + e) * DM);
                acc0 = fmaf(av[e], bv.x, acc0); acc1 = fmaf(av[e], bv.y, acc1); acc2 = fmaf(av[e], bv.z, acc2); acc3 = fmaf(av[e], bv.w, acc3);
            }
        }
        const float sc = (sec == 0) ? 1.0f : ((sec == 1) ? 0.125f : -0.125f);
        bf16_t* op = wot + (size_t)n0 * YW + sec * 256 + g * 64 + lane;
        op[0] = bf1(acc0 * sc); op[YW] = bf1(acc1 * sc); op[2 * YW] = bf1(acc2 * sc); op[3 * YW] = bf1(acc3 * sc);
    }
}

__device__ __forceinline__ void pool_unit(const bf16_t* P, bf16_t* ycat, int unit) {
    const int tid = fresh_tid(), chunk = tid & 31, trow = tid >> 5, g = chunk >> 3, w = 2 << g, left = w >> 1, right = w - 1 - left;
#pragma unroll 1
    for (int i = 0; i < 4; ++i) {
        const int t = unit * 64 + trow + 16 * i, b = t >> 13, s = t & (SEQ - 1);
        const int lo = max(s - left, 0), hi = min(s + right + 1, SEQ);
        u32x4 v[16];
#pragma unroll
        for (int j = 0; j < 16; ++j) { const int p = min(max(s - 8 + j, 0), SEQ - 1); v[j] = *(const u32x4*)(P + (size_t)(b * SEQ + p) * PW + chunk * 8); }
        float acc[8];
#pragma unroll
        for (int e = 0; e < 8; ++e) acc[e] = 0.f;
#pragma unroll
        for (int j = 0; j < 16; ++j) {
            const int p = s - 8 + j; const float wgt = (p >= lo && p < hi) ? 1.0f : 0.0f;
            acc[0] = fmaf(wgt, __uint_as_float(v[j].x << 16), acc[0]); acc[1] = fmaf(wgt, __uint_as_float(v[j].x & 0xffff0000u), acc[1]);
            acc[2] = fmaf(wgt, __uint_as_float(v[j].y << 16), acc[2]); acc[3] = fmaf(wgt, __uint_as_float(v[j].y & 0xffff0000u), acc[3]);
            acc[4] = fmaf(wgt, __uint_as_float(v[j].z << 16), acc[4]); acc[5] = fmaf(wgt, __uint_as_float(v[j].z & 0xffff0000u), acc[5]);
            acc[6] = fmaf(wgt, __uint_as_float(v[j].w << 16), acc[6]); acc[7] = fmaf(wgt, __uint_as_float(v[j].w & 0xffff0000u), acc[7]);
        }
        const u32x4 c = v[8];
        const float ic = 1.0f / (float)(hi - lo);
        u32x4 o;
        o.x = pk2(acc[0] * ic - __uint_as_float(c.x << 16), acc[1] * ic - __uint_as_float(c.x & 0xffff0000u));
        o.y = pk2(acc[2] * ic - __uint_as_float(c.y << 16), acc[3] * ic - __uint_as_float(c.y & 0xffff0000u));
        o.z = pk2(acc[4] * ic - __uint_as_float(c.z << 16), acc[5] * ic - __uint_as_float(c.z & 0xffff0000u));
        o.w = pk2(acc[6] * ic - __uint_as_float(c.w << 16), acc[7] * ic - __uint_as_float(c.w & 0xffff0000u));
        *(u32x4*)(ycat + (size_t)t * YW + chunk * 8) = o;
    }
}

__device__ __forceinline__ void fa_unit(LAS unsigned char* lds, const bf16_t* P, bf16_t* GP, const unsigned char* tb, int b, int s2) {
    const int tid = fresh_tid(), lane = tid & 63, r32 = lane & 31, hi = lane >> 5, wid = __builtin_amdgcn_readfirstlane(tid >> 6);
#pragma unroll
    for (int i = 0; i < 4; ++i) {
        const int idx = tid + 512 * i, s1 = idx >> 5, ch = idx & 31;
        const u32x4 v = *(const u32x4*)(P + (size_t)(b * SEQ + 128 * s1 + s2) * PW + 256 + ch * 8);
        *(LAS u32x4*)(lds + (ch >> 2) * 4096 + s1 * 64 + (ch & 3) * 16) = v;
    }
    __syncthreads();
    const int i16 = lane & 15, q = i16 >> 2, p = i16 & 3, blk = (lane >> 4) & 1;
    const LAS unsigned char* bp = lds + wid * 4096 + (8 * hi + q) * 64 + blk * 32 + p * 8;
    bf16x8 bfr[4];
#pragma unroll
    for (int s = 0; s < 4; ++s) bfr[s] = cat8(vtr(bp + s * 1024), vtr(bp + s * 1024 + 256));
    const bf16_t* T64c = (const bf16_t*)(tb + TB_64C); const bf16_t* T64s = (const bf16_t*)(tb + TB_64S);
    const float* twc = (const float*)(tb + TB_TWC) + s2 * 64; const float* tws = (const float*)(tb + TB_TWS) + s2 * 64;
#pragma unroll
    for (int mt = 0; mt < 2; ++mt) {
        f32x16 gr, gs;
#pragma unroll
        for (int r = 0; r < 16; ++r) { gr[r] = 0.f; gs[r] = 0.f; }
#pragma unroll
        for (int s = 0; s < 4; ++s) {
            const bf16x8 ac = *(const bf16x8*)(T64c + (32 * mt + r32) * 64 + 16 * s + 8 * hi);
            const bf16x8 as = *(const bf16x8*)(T64s + (32 * mt + r32) * 64 + 16 * s + 8 * hi);
            gr = MFMA32(ac, bfr[s], gr); gs = MFMA32(as, bfr[s], gs);
        }
#pragma unroll
        for (int r = 0; r < 16; ++r) {
            const int k1 = 32 * mt + crow(r, hi);
            const float c = twc[k1], sn = tws[k1], Gr = gr[r], Gi = -gs[r];
            const float pr = (Gr * c + Gi * sn) * 0.125f, pi = (Gi * c - Gr * sn) * 0.125f;
            bf16_t* gp = GP + ((size_t)((b * 64 + k1) * 128 + s2) * 2) * 256 + wid * 32 + r32;
            gp[0] = bf1(pr); gp[256] = bf1(pi);
        }
    }
    __syncthreads();
}
__device__ __forceinline__ void fc_unit(LAS unsigned char* lds, const bf16_t* GP, bf16_t* ycat, const unsigned char* tb, int b, int k1, int chalf) {
    const int tid = fresh_tid(), lane = tid & 63, r32 = lane & 31, hi = lane >> 5, wid = __builtin_amdgcn_readfirstlane(tid >> 6);
    const bf16_t* gsrc = GP + (size_t)(b * 64 + k1) * 128 * 2 * 256 + chalf * 128;
#pragma unroll
    for (int i = 0; i < 8; ++i) {
        const int idx = tid + 512 * i, row = idx >> 4, ch = idx & 15, s2 = row >> 1, ri = row & 1;
        const u32x4 v = *(const u32x4*)(gsrc + (size_t)row * 256 + ch * 8);
        *(LAS u32x4*)(lds + ((ch >> 2) * 2 + ri) * 8192 + s2 * 64 + (ch & 3) * 16) = v;
    }
    __syncthreads();
    const int cblk = wid & 3, kh = wid >> 2;
    const int i16 = lane & 15, q = i16 >> 2, p = i16 & 3, blk = (lane >> 4) & 1;
    const LAS unsigned char* bpr = lds + (cblk * 2) * 8192 + (8 * hi + q) * 64 + blk * 32 + p * 8;
    const LAS unsigned char* bpi = bpr + 8192;
    const bf16_t* T128c = (const bf16_t*)(tb + TB_128C); const bf16_t* T128s = (const bf16_t*)(tb + TB_128S);
    f32x16 xr[2], sf[2];
#pragma unroll
    for (int mt = 0; mt < 2; ++mt)
#pragma unroll
        for (int r = 0; r < 16; ++r) { xr[mt][r] = 0.f; sf[mt][r] = 0.f; }
#pragma unroll
    for (int s = 0; s < 8; ++s) {
        const bf16x8 br = cat8(vtr(bpr + s * 1024), vtr(bpr + s * 1024 + 256));
        const bf16x8 bi = cat8(vtr(bpi + s * 1024), vtr(bpi + s * 1024 + 256));
#pragma unroll
        for (int mt = 0; mt < 2; ++mt) {
            const int krow = 32 * (2 * kh + mt) + r32;
            const bf16x8 ac = *(const bf16x8*)(T128c + krow * 128 + 16 * s + 8 * hi);
            const bf16x8 as = *(const bf16x8*)(T128s + krow * 128 + 16 * s + 8 * hi);
            const bf16x8 nc = ac ^ (short)0x8000;
            xr[mt] = MFMA32(ac, br, xr[mt]); xr[mt] = MFMA32(as, bi, xr[mt]);
            sf[mt] = MFMA32(as, br, sf[mt]); sf[mt] = MFMA32(nc, bi, sf[mt]);
        }
    }
    const float sc = 0.08838834764831845f;
#pragma unroll
    for (int mt = 0; mt < 2; ++mt)
#pragma unroll
        for (int r = 0; r < 16; ++r) {
            const int k2 = 32 * (2 * kh + mt) + crow(r, hi), k = k1 + 64 * k2;
            bf16_t* yp = ycat + (size_t)(b * SEQ + k) * YW + 256 + chalf * 128 + cblk * 32 + r32;
            yp[0] = bf1(xr[mt][r] * sc); yp[256] = bf1(sf[mt][r] * sc);
        }
    __syncthreads();
}

constexpr int AT_KB = 17408, AT_VS = 4096, AT_VB = 4 * AT_VS, AT_VOFF = 2 * AT_KB, AT_MISC = AT_VOFF + 3 * AT_VB;
__device__ __forceinline__ float wave_max(float v) {
#pragma unroll
    for (int o = 1; o < 64; o <<= 1) v = fmaxf(v, __shfl_xor(v, o));
    return v;
}
__device__ __forceinline__ float wave_min(float v) {
#pragma unroll
    for (int o = 1; o < 64; o <<= 1) v = fminf(v, __shfl_xor(v, o));
    return v;
}
#pragma float_control(push)
#pragma float_control(precise, off)
__device__ __forceinline__ float rowmax32(const f32x16& a, const f32x16& b) {
    float m0 = __builtin_fmaxf(a[0], b[0]), m1 = __builtin_fmaxf(a[1], b[1]);
#pragma unroll
    for (int r = 2; r < 16; r += 2) { m0 = __builtin_fmaxf(m0, __builtin_fmaxf(a[r], b[r])); m1 = __builtin_fmaxf(m1, __builtin_fmaxf(a[r + 1], b[r + 1])); }
    return __builtin_fmaxf(m0, m1);
}
#pragma float_control(pop)
__device__ __forceinline__ float bflo(unsigned u) { return __uint_as_float(u << 16); }
__device__ __forceinline__ float bfhi(unsigned u) { return __uint_as_float(u & 0xffff0000u); }
__device__ __forceinline__ void knorm_items(const bf16_t* KC, float* knmax) {
    const int tid = fresh_tid(), lane = tid & 63, wave = tid >> 6;
    for (int item = blockIdx.x * 8 + wave; item < 2048; item += gridDim.x * 8) {
        const int tile = item & 127, j = (item >> 7) & 1, h = (item >> 8) & 3, b = item >> 10;
        const bf16_t* kp = KC + ((size_t)((b * 4 + h) * SEQ + tile * 64 + lane)) * 128 + j * 64;
        float s = 0.f;
#pragma unroll
        for (int i = 0; i < 8; ++i) {
            const u32x4 v = *(const u32x4*)(kp + 8 * i);
            s += (bflo(v.x) * bflo(v.x) + bfhi(v.x) * bfhi(v.x)) + (bflo(v.y) * bflo(v.y) + bfhi(v.y) * bfhi(v.y)) + (bflo(v.z) * bflo(v.z) + bfhi(v.z) * bfhi(v.z)) + (bflo(v.w) * bflo(v.w) + bfhi(v.w) * bfhi(v.w));
        }
        const float n = wave_max(sqrtf(s));
        if (lane == 0) knmax[item] = n;
    }
}
__device__ __forceinline__ void attn_unit(LAS unsigned char* lds, const bf16_t* QC, bf16_t* ycat, const float* knmax, int b, int h, int qb, float lam, float outscale, const float* hn) {
    const int tid = fresh_tid(), lane = tid & 63, r32 = lane & 31, hi = lane >> 5, wid = __builtin_amdgcn_readfirstlane(tid >> 6);
    const int j = wid & 1, qs = wid >> 1, q0 = qb * 128 + qs * 32;
    const size_t rowbase = (size_t)b * SEQ;
    LAS float* knl = (LAS float*)(lds + AT_MISC); LAS float* red = knl + 256;
    bf16x8 qf[4];
    {
        const bf16_t* Qp = QC + ((size_t)((b * 4 + h) * SEQ + q0 + r32)) * 128 + j * 64 + 8 * hi;
#pragma unroll
        for (int s = 0; s < 4; ++s) qf[s] = *(const bf16x8*)(Qp + 16 * s);
        float q2 = 0.f;
#pragma unroll
        for (int s = 0; s < 4; ++s) { const u32x4 w = __builtin_bit_cast(u32x4, qf[s]);
            q2 += (bflo(w.x) * bflo(w.x) + bfhi(w.x) * bfhi(w.x)) + (bflo(w.y) * bflo(w.y) + bfhi(w.y) * bfhi(w.y)) + (bflo(w.z) * bflo(w.z) + bfhi(w.z) * bfhi(w.z)) + (bflo(w.w) * bflo(w.w) + bfhi(w.w) * bfhi(w.w)); }
        q2 += __shfl_xor(q2, 32);
        const float qn = wave_max(sqrtf(q2));
        if (lane == 0) red[wid] = qn;
        if (tid < 256) knl[tid] = knmax[(b * 4 + h) * 256 + tid];
    }
    const int key0 = tid >> 4, ch = tid & 15;
    const bf16_t* Ksrc = QC + (8u << 20) + ((size_t)((b * 4 + h) * SEQ)) * 128 + tid * 8;
    const int kdst = key0 * 272 + ch * 16, vdst = AT_VOFF + (ch >> 2) * AT_VS + key0 * 64 + (ch & 3) * 16;
    u32x4 ska0, ska1, sva0, sva1;
#define AT_LOAD(S, t) do { const bf16_t* kp_ = Ksrc + (size_t)(t) * 8192; sk##S##0 = *(const u32x4*)kp_; sk##S##1 = *(const u32x4*)(kp_ + 4096); sv##S##0 = *(const u32x4*)(kp_ + (8u << 20)); sv##S##1 = *(const u32x4*)(kp_ + (8u << 20) + 4096); } while (0)
#define AT_STORE(S, kb_, vb_) do { *(LAS u32x4*)(lds + (kb_) * AT_KB + kdst) = sk##S##0; *(LAS u32x4*)(lds + (kb_) * AT_KB + kdst + 32 * 272) = sk##S##1; \
        *(LAS u32x4*)(lds + (vb_) * AT_VB + vdst) = sv##S##0; *(LAS u32x4*)(lds + (vb_) * AT_VB + vdst + 32 * 64) = sv##S##1; } while (0)
    f32x16 o[4];
#pragma unroll
    for (int et = 0; et < 4; ++et)
#pragma unroll
        for (int r = 0; r < 16; ++r) o[et][r] = 0.f;
    float m = -64.0f, l = 0.f;
    const float cb = exp2f(-2.0f * (float)(h + 1)) * LOG2E;
    const float qpos = (float)(q0 + r32);
    const int i16 = lane & 15, tq = i16 >> 2, tp = i16 & 3, blk = (lane >> 4) & 1;
    const int koff = r32 * 272 + (64 * j + 8 * hi) * 2;
    const int voff = AT_VOFF + (4 * hi + tq) * 64 + blk * 32 + tp * 8;
    const int td0 = 2 * qb;
    u32x4 ab0 = {0u, 0u, 0u, 0u}, ab1 = {0u, 0u, 0u, 0u};
    if (hi == 0) {
        const float c0 = cb * (float)r32, c1 = cb * (float)(r32 + 32);
        const unsigned h0 = pk2(c0, 0.f) & 0xffffu, h1 = pk2(c1, 0.f) & 0xffffu;
        ab0.x = h0 | (pk2(c0 - __uint_as_float(h0 << 16), 0.f) << 16);
        ab1.x = h1 | (pk2(c1 - __uint_as_float(h1 << 16), 0.f) << 16);
    }
    const bool grpB = wid >= 4;
    bf16x8 pa[4];
#pragma unroll
    for (int ks = 0; ks < 4; ++ks) pa[ks] = (bf16x8){0, 0, 0, 0, 0, 0, 0, 0};
#define AT_SEQ(i) ((i) < 2 ? td0 + (i) : (((i) - 2 < td0) ? td0 - 1 - ((i) - 2) : (i)))
#define SB() __builtin_amdgcn_sched_barrier(0)
#define AT_VRD(dst, ks) do { _Pragma("unroll") for (int et = 0; et < 4; ++et) dst[et] = cat8(vtr(vp_ + et * AT_VS + (ks) * 1024), vtr(vp_ + et * AT_VS + (ks) * 1024 + 512)); } while (0)
#define AT_VMM(src, ks) do { _Pragma("unroll") for (int et = 0; et < 4; ++et) o[et] = MFMA32(src[et], pa[ks], o[et]); } while (0)
#define AT_PV(vbuf) do { const LAS unsigned char* vp_ = lds + (vbuf) * AT_VB + voff; \
        _Pragma("unroll") for (int ks = 0; ks < 4; ++ks) _Pragma("unroll") for (int et = 0; et < 4; ++et) { \
            const bf16x8 vf_ = cat8(vtr(vp_ + et * AT_VS + ks * 1024), vtr(vp_ + et * AT_VS + ks * 1024 + 512)); o[et] = MFMA32(vf_, pa[ks], o[et]); } } while (0)
    int T = td0;
    AT_LOAD(a, T); AT_STORE(a, 0, 0);
    __syncthreads();
    const float qmax0 = fmaxf(fmaxf(red[0], red[2]), fmaxf(red[4], red[6])), qmax1 = fmaxf(fmaxf(red[1], red[3]), fmaxf(red[5], red[7]));
    float thr0 = -3e38f, thr1 = -3e38f;
    int kbuf = 0, vbuf = 0, vprev = 0, i = 0;
#pragma unroll 1
    for (;;) {
        int in = i + 1, Tn = -1;
        while (in < SEQ / 64) {
            const int Tc = AT_SEQ(in);
            if (in < 3) { Tn = Tc; break; }
            const float dmin = (Tc < td0) ? (float)(128 * qb - 64 * Tc - 63) : (float)(64 * Tc - 128 * qb - 127);
            if (qmax0 * knl[Tc] - cb * dmin + 1.0f >= thr0 || qmax1 * knl[128 + Tc] - cb * dmin + 1.0f >= thr1) { Tn = Tc; break; }
            ++in;
        }
        if (Tn >= 0) AT_LOAD(a, Tn);
        if (grpB && i > 0) AT_PV(vprev);
        f32x16 S0, S1;
        const bool offd = (i >= 2);
        float tadd = 0.f;
        u32x4 bb = {0u, 0u, 0u, 0u};
        if (offd) { const bool left = T < td0; bb.x = (hi == 0) ? (left ? 0x3F803F80u : 0xBF80BF80u) : 0u; const float tt = cb * ((float)(64 * T) - qpos); tadd = left ? tt : -tt; }
        {
            const float c0 = tadd - m;
#pragma unroll
            for (int r = 0; r < 16; ++r) { S0[r] = c0; S1[r] = c0; }
            const LAS unsigned char* kp = lds + kbuf * AT_KB + koff;
#pragma unroll
            for (int s = 0; s < 4; ++s) {
                const bf16x8 k0 = *(const LAS bf16x8*)(kp + s * 32), k1 = *(const LAS bf16x8*)(kp + 32 * 272 + s * 32);
                S0 = MFMA32(k0, qf[s], S0); S1 = MFMA32(k1, qf[s], S1);
            }
            S0 = MFMA32(__builtin_bit_cast(bf16x8, ab0), __builtin_bit_cast(bf16x8, bb), S0); S1 = MFMA32(__builtin_bit_cast(bf16x8, ab1), __builtin_bit_cast(bf16x8, bb), S1);
        }
        if (!offd) {
            const float kb = (float)(T * 64 + 4 * hi) - qpos;
#pragma unroll
            for (int r = 0; r < 16; ++r) {
                const float d0 = kb + (float)((r & 3) + 8 * (r >> 2));
                S0[r] = fmaf(-cb, fabsf(d0), S0[r]); S1[r] = fmaf(-cb, fabsf(d0 + 32.0f), S1[r]);
            }
        }
        {
            float mt = rowmax32(S0, S1);
            { const auto sw_ = __builtin_amdgcn_permlane32_swap(__float_as_uint(mt), __float_as_uint(mt), false, false); mt = fmaxf(__uint_as_float(sw_[0]), __uint_as_float(sw_[1])); }
            if (__any(mt > 0.f)) {
                const float dl = fmaxf(mt, 0.f), f = __builtin_amdgcn_exp2f(-dl);
                l *= f; m += dl;
#pragma unroll
                for (int et = 0; et < 4; ++et) o[et] = o[et] * f;
                S0 = S0 - dl; S1 = S1 - dl;
            }
        }
        f32x2 ls2 = {0.f, 0.f};
#pragma unroll
        for (int r = 0; r < 16; r += 2) {
            S0[r] = __builtin_amdgcn_exp2f(S0[r]); S0[r + 1] = __builtin_amdgcn_exp2f(S0[r + 1]); S1[r] = __builtin_amdgcn_exp2f(S1[r]); S1[r + 1] = __builtin_amdgcn_exp2f(S1[r + 1]);
            ls2 = ls2 + (f32x2){S0[r], S0[r + 1]}; ls2 = ls2 + (f32x2){S1[r], S1[r + 1]};
        }
        l += ls2.x + ls2.y;
        { u32x4 w;
          w.x = pk2(S0[0], S0[1]); w.y = pk2(S0[2], S0[3]); w.z = pk2(S0[4], S0[5]); w.w = pk2(S0[6], S0[7]); pa[0] = __builtin_bit_cast(bf16x8, w);
          w.x = pk2(S0[8], S0[9]); w.y = pk2(S0[10], S0[11]); w.z = pk2(S0[12], S0[13]); w.w = pk2(S0[14], S0[15]); pa[1] = __builtin_bit_cast(bf16x8, w);
          w.x = pk2(S1[0], S1[1]); w.y = pk2(S1[2], S1[3]); w.z = pk2(S1[4], S1[5]); w.w = pk2(S1[6], S1[7]); pa[2] = __builtin_bit_cast(bf16x8, w);
          w.x = pk2(S1[8], S1[9]); w.y = pk2(S1[10], S1[11]); w.z = pk2(S1[12], S1[13]); w.w = pk2(S1[14], S1[15]); pa[3] = __builtin_bit_cast(bf16x8, w); }
        if (!grpB) AT_PV(vbuf);
        if (i == 1) { const float wm = wave_min(m > -64.0f ? m : -3e38f); if (lane == 0) red[8 + wid] = wm; }
        const int vnext = (vbuf == 2) ? 0 : vbuf + 1;
        if (Tn >= 0) AT_STORE(a, kbuf ^ 1, vnext);
        __syncthreads();
        if (i == 1) { thr0 = fminf(fminf(red[8], red[10]), fminf(red[12], red[14])) - 41.0f; thr1 = fminf(fminf(red[9], red[11]), fminf(red[13], red[15])) - 41.0f; }
        vprev = vbuf;
        if (Tn < 0) break;
        i = in; T = Tn; kbuf ^= 1; vbuf = vnext;
    }
    if (grpB) AT_PV(vprev);
    __syncthreads();
#undef AT_PV
#undef AT_VRD
#undef AT_VMM
#undef SB
#undef AT_LOAD
#undef AT_STORE
#undef AT_SEQ
    l += __shfl_xor(l, 32);
    float inv = 1.0f / l; if (j == 1) inv *= lam;
    LAS float* xb = (LAS float*)lds + qs * 4096;
    if (j == 1) {
#pragma unroll
        for (int et = 0; et < 4; ++et)
#pragma unroll
            for (int r = 0; r < 16; ++r) xb[(32 * et + crow(r, hi)) * 32 + r32] = o[et][r] * inv;
    }
    __syncthreads();
    if (j == 0) {
        float sq = 0.f;
#pragma unroll
        for (int et = 0; et < 4; ++et)
#pragma unroll
            for (int r = 0; r < 16; ++r) { const float d = o[et][r] * inv - xb[(32 * et + crow(r, hi)) * 32 + r32]; o[et][r] = d; sq += d * d; }
        sq += __shfl_xor(sq, 32);
        const float rn = rsqrtf(sq * (1.0f / 128.0f) + EPS) * outscale;
        bf16_t* yo = ycat + (rowbase + q0 + r32) * YW + 768 + h * 128;
#pragma unroll
        for (int et = 0; et < 4; ++et)
#pragma unroll
            for (int g = 0; g < 4; ++g) {
                const int e0 = 32 * et + 8 * g + 4 * hi;
                const f32x4 hv = *(const f32x4*)(hn + h * 128 + e0);
                u32x2 w; w.x = pk2(o[et][4 * g] * rn * hv.x, o[et][4 * g + 1] * rn * hv.y); w.y = pk2(o[et][4 * g + 2] * rn * hv.z, o[et][4 * g + 3] * rn * hv.w);
                *(u32x2*)(yo + e0) = w;
            }
    }
    __syncthreads();
}

__device__ __forceinline__ void phase_final(CArgs* a) {
    const int tid = fresh_tid(), lane = tid & 63, wave = tid >> 6;
    const bf16_t* xl = (const bf16_t*)(a->ws + WS_XF); const bf16_t* xh = (const bf16_t*)(a->ws + WS_XB);
    const float* ss = (const float*)(a->ws + WS_SS) + (size_t)12 * MTOK * 16; const float* gn = a->in[20];
    f32x4 g[4];
#pragma unroll
    for (int j = 0; j < 4; ++j) g[j] = ((const f32x4*)gn)[lane + 64 * j];
    for (int row0 = blockIdx.x * 8 + wave; row0 < MTOK; row0 += gridDim.x * 16) {
        const int row1 = row0 + gridDim.x * 8; const bool has1 = row1 < MTOK; const int r1 = has1 ? row1 : row0;
        const u32x2* hr0 = (const u32x2*)(xh + (size_t)row0 * DM) + lane; const u32x2* lr0 = (const u32x2*)(xl + (size_t)row0 * DM) + lane;
        const u32x2* hr1 = (const u32x2*)(xh + (size_t)r1 * DM) + lane; const u32x2* lr1 = (const u32x2*)(xl + (size_t)r1 * DM) + lane;
        u32x2 h0[4], h1[4];
#pragma unroll
        for (int j = 0; j < 4; ++j) { h0[j] = hr0[64 * j]; h1[j] = hr1[64 * j]; }
        const float ra = row_rs(ss, row0), rb = row_rs(ss, r1);
        f32x4* oo0 = (f32x4*)(a->out + (size_t)row0 * DM) + lane; f32x4* oo1 = (f32x4*)(a->out + (size_t)r1 * DM) + lane;
#pragma unroll
        for (int j = 0; j < 4; ++j) {
            const f32x4 x = {__uint_as_float(h0[j].x << 16), __uint_as_float(h0[j].x & 0xffff0000u), __uint_as_float(h0[j].y << 16), __uint_as_float(h0[j].y & 0xffff0000u)};
            __builtin_nontemporal_store(x * ra * g[j], oo0 + 64 * j);
        }
        if (has1) {
#pragma unroll
            for (int j = 0; j < 4; ++j) {
                const f32x4 x = {__uint_as_float(h1[j].x << 16), __uint_as_float(h1[j].x & 0xffff0000u), __uint_as_float(h1[j].y << 16), __uint_as_float(h1[j].y & 0xffff0000u)};
                __builtin_nontemporal_store(x * rb * g[j], oo1 + 64 * j);
            }
        }
    }
}

__device__ __forceinline__ void grid_bar(unsigned* ctr, unsigned target) {
    __syncthreads();
    if (fresh_tid() == 0) {
        __builtin_amdgcn_fence(__ATOMIC_RELEASE, "agent");
        __hip_atomic_fetch_add(ctr, 1u, __ATOMIC_RELAXED, __HIP_MEMORY_SCOPE_AGENT);
        while (__hip_atomic_load(ctr, __ATOMIC_RELAXED, __HIP_MEMORY_SCOPE_AGENT) < target) __builtin_amdgcn_s_sleep(2);
        __builtin_amdgcn_fence(__ATOMIC_ACQUIRE, "agent");
    }
    __syncthreads();
}
__device__ __forceinline__ void grid_bar2(unsigned* xarr, unsigned* top, unsigned nb, unsigned per) {
    asm volatile("s_waitcnt vmcnt(0)" ::: "memory");
    __syncthreads();
    if (fresh_tid() == 0) {
        const unsigned old = __hip_atomic_fetch_add(xarr, 1u, __ATOMIC_RELAXED, __HIP_MEMORY_SCOPE_AGENT);
        if (old + 1u == nb * per) { __builtin_amdgcn_fence(__ATOMIC_RELEASE, "agent"); __hip_atomic_fetch_add(top, 1u, __ATOMIC_RELAXED, __HIP_MEMORY_SCOPE_AGENT); }
        while (__hip_atomic_load(top, __ATOMIC_RELAXED, __HIP_MEMORY_SCOPE_AGENT) < nb * 8u) __builtin_amdgcn_s_sleep(2);
        __builtin_amdgcn_fence(__ATOMIC_ACQUIRE, "agent");
    }
    __syncthreads();
}
__device__ __forceinline__ unsigned xcc_id() { return (unsigned)__builtin_amdgcn_s_getreg((3 << 11) | 20) & 0xFu; }
__device__ __forceinline__ void xcd_bar(unsigned* ctr, unsigned target) {
    asm volatile("s_waitcnt vmcnt(0)" ::: "memory");
    __syncthreads();
    if (fresh_tid() == 0) {
        __hip_atomic_fetch_add(ctr, 1u, __ATOMIC_RELAXED, __HIP_MEMORY_SCOPE_AGENT);
        while (__hip_atomic_load(ctr, __ATOMIC_RELAXED, __HIP_MEMORY_SCOPE_AGENT) < target) __builtin_amdgcn_s_sleep(1);
        __builtin_amdgcn_fence(__ATOMIC_ACQUIRE, "agent");
    }
    __syncthreads();
}
__global__ void __launch_bounds__(512, 2) mega_fwd(Args a_val) {
    extern __shared__ __attribute__((aligned(16))) unsigned char lds_raw[];
    LAS unsigned char* lds = (LAS unsigned char*)lds_raw;
    const int ph_lo = a_val.ph_lo, ph_hi = a_val.ph_hi, coop = a_val.coop;
    unsigned nbar = 0, nxbar = 0, nbar2 = 0;
    LAS unsigned* blk = (LAS unsigned*)(lds + LDS_BYTES - 32);
    if (coop && ph_lo == 0) {
        if (fresh_tid() == 0) { const unsigned x = xcc_id() & 7u; blk[2] = x; blk[0] = __hip_atomic_fetch_add((unsigned*)(a_val.ws + WS_MISC + 640) + x, 1u, __ATOMIC_RELAXED, __HIP_MEMORY_SCOPE_AGENT) * 8u + x; blk[1] = 0u; }
    } else if (fresh_tid() == 0) { blk[0] = blockIdx.x; blk[1] = 0u; blk[2] = 0u; }
    __syncthreads();
    for (int ph = ph_lo; ph < ph_hi; ++ph) {
        CArgs* a = (CArgs*)__builtin_amdgcn_kernarg_segment_ptr();
        asm volatile("" : "+s"(a));
        unsigned char* ws = a->ws;
        float* xf = (float*)(ws + WS_XF); bf16_t* xb = (bf16_t*)(ws + WS_XB); float* ssb = (float*)(ws + WS_SS);
        bf16_t* act = (bf16_t*)(ws + WS_ACT); bf16_t* P = (bf16_t*)(ws + WS_P); bf16_t* ycat = (bf16_t*)(ws + WS_YCAT); bf16_t* GP = (bf16_t*)(ws + WS_GP);
        const unsigned char* tb = ws + WS_TAB;
        if (ph == 0) phase_p0(a, lds);
        else if (ph == NPHASE - 1) phase_final(a);
        else {
            const int l = (ph - 1) >> 3, k = (ph - 1) & 7;
            unsigned char* wb = wbuf(ws, l);
            for (int rep = 0; rep < (((PROBE_MASK >> k) & 1) ? 2 : 1); ++rep) {
            if (k == 0 || k == 6) {
                pg8::Gemm g{xb, (const bf16_t*)(wb + (k == 0 ? W_GU1 : W_GU2)), MTOK, 2 * DFF, DM}; pg8::StaticOrder S; S.init(MTOK, 2 * DFF, gridDim.x, (int)blk[0]);
                EpiSwiGLU E{act, ssb + (size_t)(3 * l + (k == 0 ? 0 : 2)) * MTOK * 16};
                pg8::gemm_phase<EpiSwiGLU, pg8::StaticOrder, true, true>(lds, g, S, E);
            } else if (k == 1 || k == 7 || k == 5) {
                const bf16_t* A = (k == 5) ? ycat : act; const int K = (k == 5) ? YW : DFF;
                const bf16_t* Bt = (const bf16_t*)(wb + (k == 1 ? W_D1 : (k == 7 ? W_D2 : W_O)));
                pg8::Gemm g{A, Bt, MTOK, DM, K}; pg8::StaticOrder S; S.init(MTOK, DM, gridDim.x, (int)blk[0]);
                EpiResid E{(l == 0 && k == 1) ? a->in[0] : (const float*)nullptr, (bf16_t*)xf, xb, ssb + (size_t)(3 * l + (k == 1 ? 1 : (k == 5 ? 2 : 3))) * MTOK * 16, (k == 5) ? 1.0f : 0.5f};
                pg8::gemm_phase<EpiResid, pg8::StaticOrder, true, true>(lds, g, S, E);
            } else if (k == 2) {
                pg8::Gemm g{xb, (const bf16_t*)(wb + W_IN), MTOK, 2048, DM}; pg8::StaticOrder S; S.init(MTOK, 2048, gridDim.x, (int)blk[0]);
                EpiWin E{P, (bf16_t*)(ws + WS_QC), ssb + (size_t)(3 * l + 1) * MTOK * 16};
                pg8::gemm_phase<EpiWin, pg8::StaticOrder, true, true>(lds, g, S, E);
            } else if (k == 3) {
                for (int u = blockIdx.x; u < 256; u += gridDim.x) fa_unit(lds, P, GP, tb, u >> 7, u & 127);
                for (int u = blockIdx.x; u < 256; u += gridDim.x) pool_unit(P, ycat, u);
                knorm_items((const bf16_t*)(ws + WS_KC), (float*)(ws + WS_MISC + 1024));
                fold_wout(a, l);
            } else {
                const float lam = ((const float*)(ws + WS_MISC))[l];
                const float outscale = 1.0f - (0.8f - 0.6f * expf(-0.3f * (float)l));
                unsigned* ctr = (unsigned*)(ws + WS_MISC + 256) + l;
                LAS int* uslot = (LAS int*)(lds + AT_MISC + 1024 + 64);
                const int nwork = 768 + ((l + 1 < NLAYER) ? CONV_CHUNKS : 0);
                for (;;) {
                    if (fresh_tid() == 0) *uslot = (int)atomicAdd(ctr, 1u);
                    __syncthreads();
                    const int u = *uslot;
                    __syncthreads();
                    if (u >= nwork) break;
                    if (u >= 512 && u < 768) { const int v = u - 512; fc_unit(lds, GP, ycat, tb, v >> 7, (v >> 1) & 63, v & 1); }
                    else if (u < 512) attn_unit(lds, (const bf16_t*)(ws + WS_QC), ycat, (const float*)(ws + WS_MISC + 1024), (u >> 6) & 1, 3 - (u >> 7), u & 63, lam, outscale, a->in[14] + l * 512);
                    else conv_chunk(a, l + 1, u - 768, lds);
                }
            }
            }
        }
        if (coop && ph + 1 < ph_hi) {
            if (coop == 2) cg::this_grid().sync();
            else {
                const int kk = (ph - 1) & 7;
                const bool local = blk[1] != 0u && ph >= 1 && ph < NPHASE - 2 && (kk == 0 || kk == 1 || kk >= 5);
                if (local) { ++nxbar; xcd_bar((unsigned*)(ws + WS_MISC + 704) + blk[2], nxbar * (gridDim.x >> 3)); }
                else if (blk[1] != 0u) { ++nbar2; grid_bar2((unsigned*)(ws + WS_MISC + 576) + blk[2], (unsigned*)(ws + WS_MISC + 516), nbar2, gridDim.x >> 3); }
                else { ++nbar; grid_bar((unsigned*)(ws + WS_MISC + 512), nbar * gridDim.x); }
                if (ph == 0) {
                    if (fresh_tid() == 0) {
                        bool even = (gridDim.x & 7u) == 0u;
                        for (int x = 0; x < 8; ++x) even = even && (__hip_atomic_load((unsigned*)(ws + WS_MISC + 640) + x, __ATOMIC_RELAXED, __HIP_MEMORY_SCOPE_AGENT) == (gridDim.x >> 3));
                        if (even) blk[1] = 1u; else blk[0] = blockIdx.x;
                    }
                    __syncthreads();
                }
            }
        }
    }
}

extern "C" void kernel_launch(void* const* d_in, const int* in_sizes, int n_in, void* d_out, int out_size, void* d_ws, size_t ws_size, hipStream_t stream) {
    static int grid = 0;
    if (grid == 0) {
        if (n_in != 21 || in_sizes[0] != MTOK * DM || out_size != MTOK * DM || ws_size < WS_END) {
            fprintf(stderr, "kernel_launch: unexpected problem (n_in %d, in0 %d, out %d, ws %zu); nothing launched\n", n_in, n_in > 0 ? in_sizes[0] : -1, out_size, ws_size); grid = -1; return; }
        int dev = 0, cus = 0, per_cu = 0;
        if (hipGetDevice(&dev) != hipSuccess || hipDeviceGetAttribute(&cus, hipDeviceAttributeMultiprocessorCount, dev) != hipSuccess) { fprintf(stderr, "kernel_launch: device query failed\n"); grid = -1; return; }
        if (hipFuncSetAttribute((const void*)mega_fwd, hipFuncAttributeMaxDynamicSharedMemorySize, LDS_BYTES) != hipSuccess) { fprintf(stderr, "kernel_launch: hipFuncSetAttribute failed\n"); grid = -1; return; }
        if (hipOccupancyMaxActiveBlocksPerMultiprocessor(&per_cu, (const void*)mega_fwd, 512, LDS_BYTES) != hipSuccess || per_cu < 1) { fprintf(stderr, "kernel_launch: occupancy query says %d blocks per CU\n", per_cu); per_cu = 1; }
        (void)hipGetLastError();
        grid = cus * per_cu;
    }
    if (grid < 0) return;
    Args a{};
    for (int i = 0; i < 21; ++i) a.in[i] = (const float*)d_in[i];
    a.out = (float*)d_out; a.ws = (unsigned char*)d_ws;
#if MK_MULTI
    for (int ph = 0; ph < NPHASE; ++ph) {
        a.ph_lo = ph; a.ph_hi = ph + 1; a.coop = 0;
        hipLaunchKernelGGL(mega_fwd, dim3(grid), dim3(512), LDS_BYTES, stream, a);
    }
#else
    a.ph_lo = 0; a.ph_hi = NPHASE; a.coop = 1;
    if (hipMemsetAsync((unsigned char*)d_ws + WS_MISC + 512, 0, 256, stream) != hipSuccess) { fprintf(stderr, "kernel_launch: hipMemsetAsync failed\n"); return; }
    void* args[] = {&a};
    hipError_t e = hipLaunchCooperativeKernel((const void*)mega_fwd, dim3(grid), dim3(512), args, LDS_BYTES, stream);
    if (e != hipSuccess) fprintf(stderr, "kernel_launch: cooperative launch failed: %s (grid %d)\n", hipGetErrorString(e), grid);
#endif
}
```
